# Optimizing an MI355X kernel written in HIP

```python
import jax, jax.numpy as jnp
from jax import lax
import numpy as np

D_MODEL = 1024
BATCH = 4
SEQ = 4096
DEPTH = 2

CTX_LEN = 256
GRID_W = 64
POS_BASE = 10000.0
D_FOURIER = D_MODEL // 2
FOURIER_GROUPS = 4
D_LRU = D_MODEL // 2
LRU_HEADS = 8
LRU_HEAD_DIM = D_LRU // LRU_HEADS
CONV_W = 4
LRU_C = 8.0
D_IN = D_FOURIER + 2 * D_LRU
D_MIX = D_FOURIER + D_LRU
N_EXPERTS = 16
EC_CAPACITY = 2
D_FF = 2816
N_MOD = 6
EPS = 1e-6

kernel_name = "hybrid_fourier_rglru_ec_moe_dit"


def rmsnorm(x, g):
    xf = x.astype(jnp.float32)
    y = xf * lax.rsqrt(jnp.mean(xf * xf, axis=-1, keepdims=True) + EPS) * g.astype(jnp.float32)
    return y.astype(x.dtype)


def modulate(h, shift, scale):
    return h * (1 + scale) + shift


def grid_pos_embed(rows, d):
    rr, cc = jnp.meshgrid(jnp.arange(rows, dtype=jnp.float32), jnp.arange(GRID_W, dtype=jnp.float32), indexing="ij")
    quarter = d // 4
    omega = 1.0 / (POS_BASE ** (jnp.arange(quarter, dtype=jnp.float32) / quarter))

    def enc(p):
        ang = p.reshape(-1)[:, None] * omega
        return jnp.concatenate([jnp.sin(ang), jnp.cos(ang)], axis=-1)

    return jnp.concatenate([enc(rr), enc(cc)], axis=-1)


def fourier_mix(u):
    b, n, _ = u.shape
    ug = u.astype(jnp.float32).reshape(b, n, FOURIER_GROUPS, D_FOURIER // FOURIER_GROUPS)
    y = jnp.fft.fft2(ug, axes=(1, 3), norm="ortho").real
    return y.reshape(b, n, D_FOURIER).astype(u.dtype)


def centred_dwconv(u, w, bias):
    n = u.shape[1]
    left = (CONV_W - 1) // 2
    up = jnp.pad(u, ((0, 0), (left, CONV_W - 1 - left), (0, 0)))
    y = up[:, 0:n] * w[0]
    for k in range(1, CONV_W):
        y = y + up[:, k:k + n] * w[k]
    return y + bias


def _combine(left, right):
    a_l, b_l = left
    a_r, b_r = right
    return a_l * a_r, a_r * b_l + b_r


def linear_scan(a, b, h0, reverse):
    if reverse:
        a = jnp.flip(a, axis=1)
        b = jnp.flip(b, axis=1)
    if h0 is not None:
        b = b.at[:, 0].add(a[:, 0] * h0)
    _, h = lax.associative_scan(_combine, (a, b), axis=1)
    return jnp.flip(h, axis=1) if reverse else h


def bidir_rglru(u, conv_w, conv_b, wa, ba, wi, bi, lam, h0):
    xc = centred_dwconv(u, conv_w, conv_b).astype(jnp.float32)
    bsz, n, _ = xc.shape
    xh = xc.reshape(bsz, n, LRU_HEADS, LRU_HEAD_DIM)
    y = jnp.zeros_like(xc)
    finals = []
    for dirn in range(2):
        r = jax.nn.sigmoid(jnp.einsum("bnhi,hij->bnhj", xh, wa[dirn].astype(jnp.float32)).reshape(bsz, n, D_LRU)
                           + ba[dirn].astype(jnp.float32))
        gi = jax.nn.sigmoid(jnp.einsum("bnhi,hij->bnhj", xh, wi[dirn].astype(jnp.float32)).reshape(bsz, n, D_LRU)
                            + bi[dirn].astype(jnp.float32))
        log_a = -LRU_C * r * jax.nn.softplus(-lam[dirn].astype(jnp.float32))
        a = jnp.exp(log_a)
        drive = jnp.sqrt(-jnp.expm1(2.0 * log_a)) * (gi * xc)
        init = None if h0 is None else h0[dirn]
        h = linear_scan(a, drive, init, reverse=(dirn == 1))
        y = y + h
        finals.append(h[:, -1] if dirn == 0 else h[:, 0])
    return y, (finals[0], finals[1])


def token_mixer(h, w_in, conv_w, conv_b, wa, ba, wi, bi, lam, w_out, h0):
    proj = h @ w_in
    u_f = proj[..., :D_FOURIER]
    u_x = proj[..., D_FOURIER:D_FOURIER + D_LRU]
    u_g = proj[..., D_FOURIER + D_LRU:]
    y_f = fourier_mix(u_f)
    y_r, finals = bidir_rglru(u_x, conv_w, conv_b, wa, ba, wi, bi, lam, h0)
    y_r = y_r.astype(h.dtype) * jax.nn.gelu(u_g)
    return jnp.concatenate([y_f, y_r], axis=-1) @ w_out, finals


def expert_choice_ffn(h, w_router, w_gate, w_up, w_down):
    b, n, _ = h.shape
    cap = EC_CAPACITY * n // N_EXPERTS
    aff = jax.nn.softmax(jnp.einsum("bnd,de->bne", h.astype(jnp.float32), w_router.astype(jnp.float32)), axis=-1)
    g, idx = lax.top_k(jnp.swapaxes(aff, 1, 2), cap)
    bidx = jnp.arange(b)[:, None, None]
    xg = h[bidx, idx]
    hid = jax.nn.silu(jnp.einsum("becd,edf->becf", xg, w_gate)) * jnp.einsum("becd,edf->becf", xg, w_up)
    y = jnp.einsum("becf,efd->becd", hid, w_down) * g[..., None].astype(h.dtype)
    return jnp.zeros_like(h).at[bidx, idx].add(y)


def setup_inputs(seed: int = 0) -> dict:
    key = jax.random.key(seed)
    k = jax.random.split(key, 24)
    f32 = jnp.float32
    nrm = lambda kk, shape, s: jax.random.normal(kk, shape, f32) * s
    u = jax.random.uniform(k[16], (DEPTH, 2, D_LRU), f32, minval=0.9, maxval=0.999)
    a0 = u ** (1.0 / LRU_C)
    return {
        "x": nrm(k[0], (BATCH, SEQ, D_MODEL), 1.0),
        "c": nrm(k[1], (BATCH, D_MODEL), 1.0),
        "ctx": nrm(k[2], (BATCH, CTX_LEN, D_MODEL), 1.0),
        "c_ctx": nrm(k[3], (D_MODEL,), 1.0),
        "w_mod": nrm(k[4], (DEPTH, D_MODEL, N_MOD * D_MODEL), 0.5 * D_MODEL ** -0.5),
        "b_mod": nrm(k[5], (DEPTH, N_MOD * D_MODEL), 0.02),
        "norm1_g": 1.0 + nrm(k[6], (DEPTH, D_MODEL), 0.02),
        "norm2_g": 1.0 + nrm(k[7], (DEPTH, D_MODEL), 0.02),
        "w_in": nrm(k[8], (DEPTH, D_MODEL, D_IN), D_MODEL ** -0.5),
        "conv_w": nrm(k[9], (DEPTH, CONV_W, D_LRU), CONV_W ** -0.5),
        "conv_b": nrm(k[10], (DEPTH, D_LRU), 0.02),
        "lru_wa": nrm(k[11], (DEPTH, 2, LRU_HEADS, LRU_HEAD_DIM, LRU_HEAD_DIM), LRU_HEAD_DIM ** -0.5),
        "lru_ba": nrm(k[12], (DEPTH, 2, D_LRU), 0.02),
        "lru_wi": nrm(k[13], (DEPTH, 2, LRU_HEADS, LRU_HEAD_DIM, LRU_HEAD_DIM), LRU_HEAD_DIM ** -0.5),
        "lru_bi": nrm(k[14], (DEPTH, 2, D_LRU), 0.02),
        "lru_lambda": jnp.log(a0) - jnp.log1p(-a0),
        "w_out": nrm(k[15], (DEPTH, D_MIX, D_MODEL), D_MIX ** -0.5),
        "w_router": nrm(k[17], (DEPTH, D_MODEL, N_EXPERTS), D_MODEL ** -0.5),
        "w_gate": nrm(k[18], (DEPTH, N_EXPERTS, D_MODEL, D_FF), D_MODEL ** -0.5),
        "w_up": nrm(k[19], (DEPTH, N_EXPERTS, D_MODEL, D_FF), D_MODEL ** -0.5),
        "w_down": nrm(k[20], (DEPTH, N_EXPERTS, D_FF, D_MODEL), D_FF ** -0.5),
        "final_g": 1.0 + nrm(k[21], (D_MODEL,), 0.02),
    }


def reference(x, c, ctx, c_ctx, w_mod, b_mod, norm1_g, norm2_g, w_in, conv_w, conv_b,
              lru_wa, lru_ba, lru_wi, lru_bi, lru_lambda, w_out, w_router, w_gate, w_up, w_down, final_g):
    ROWS = x.shape[1] // GRID_W
    x = x + grid_pos_embed(ROWS, x.shape[-1]).astype(x.dtype)[None]
    cond = jax.nn.silu(c)
    cond_ctx = jax.nn.silu(c_ctx)
    for l in range(DEPTH):
        last = l == DEPTH - 1
        mod = cond @ w_mod[l] + b_mod[l]
        sh1, sc1, g1, sh2, sc2, g2 = jnp.split(mod[:, None, :], N_MOD, axis=-1)
        mc = cond_ctx @ w_mod[l] + b_mod[l]
        csh1, csc1, cg1, csh2, csc2, cg2 = jnp.split(mc, N_MOD, axis=-1)
        lru_p = (conv_w[l], conv_b[l], lru_wa[l], lru_ba[l], lru_wi[l], lru_bi[l], lru_lambda[l])

        hc = modulate(rmsnorm(ctx, norm1_g[l]), csh1, csc1)
        if last:
            u_cx = hc @ w_in[l][:, D_FOURIER:D_FOURIER + D_LRU]
            _, ctx_states = bidir_rglru(u_cx, *lru_p, None)
        else:
            ctx_mix, ctx_states = token_mixer(hc, w_in[l], *lru_p, w_out[l], None)
            ctx = ctx + cg1 * ctx_mix
            hc2 = modulate(rmsnorm(ctx, norm2_g[l]), csh2, csc2)
            ctx = ctx + cg2 * expert_choice_ffn(hc2, w_router[l], w_gate[l], w_up[l], w_down[l])

        hx = modulate(rmsnorm(x, norm1_g[l]), sh1, sc1)
        x_mix, _ = token_mixer(hx, w_in[l], *lru_p, w_out[l], ctx_states)
        x = x + g1 * x_mix
        hx2 = modulate(rmsnorm(x, norm2_g[l]), sh2, sc2)
        x = x + g2 * expert_choice_ffn(hx2, w_router[l], w_gate[l], w_up[l], w_down[l])
    return rmsnorm(x, final_g)
```

```cpp
#include <hip/hip_runtime.h>
#include <cstdio>
#include <cstdint>
#define MK_SPLIT 0
#ifndef PG8_GATHER_KT_ROWS
#define PG8_GATHER_KT_ROWS 17408
#endif
#ifndef PG8_PREFETCH
#define PG8_PREFETCH 0
#endif
namespace pg8 {
#define PG8_LAS __attribute__((address_space(3)))
typedef unsigned short bf16_t;
typedef short bf16x8 __attribute__((ext_vector_type(8)));
typedef float f32x4 __attribute__((ext_vector_type(4)));
typedef unsigned u32x4 __attribute__((ext_vector_type(4)));
constexpr int BM = 256, BK = 64, HALF = 128, HTB = HALF * BK * 2  , STAGE_BYTES = 8 * HTB, NXCD = 8, WGM = 8;

__host__ __device__ __forceinline__ int lds_byte(int r, int c) { const int st = (r >> 4) * 2 + (c >> 5), rr = r & 15, cc = c & 31, ob = rr * 64 + cc * 2; return st * 1024 + (ob ^ (((ob >> 9) & 1) << 5)); }
__host__ __device__ __forceinline__ void stage_rc(int b, int& R, int& C) { const int st = b / 1024, sb = b % 1024, swz = sb ^ (((sb >> 9) & 1) << 5); R = (st >> 1) * 16 + swz / 64; C = (st & 1) * 32 + (swz % 64) / 2; }
__host__ __device__ __forceinline__ int perm32(int rho) { const int n = rho >> 4, i = rho & 15; return 8 * (i >> 2) + 4 * n + (i & 3); }

struct Unit { int pm, pn, ko; };
struct Gemm { const bf16_t* A; const bf16_t* Bt; int M, N, K, ld; const int* rowidx; };

struct StaticOrder {
    static constexpr bool GATHER = false; static constexpr int AUX_B = 0, HALF_PM = 1 << 30; static constexpr bool PF = PG8_PREFETCH;
    int nM, nN, nwg, G, c;
    __host__ __device__ void init(int M, int N, int G_, int c_) { nM = M / BM; nN = N / BM; nwg = nM * nN; G = G_; c = c_; }
    __host__ __device__ bool next(int i, Unit& u) const {
        const long L = (long)i * G + c; if (L >= nwg) return false;
        int wgid = (int)L; { const int q = nwg / NXCD, r = nwg % NXCD, xcd = wgid % NXCD, off = wgid / NXCD; wgid = (xcd < r ? xcd * (q + 1) : r * (q + 1) + (xcd - r) * q) + off; }
        const int nig = WGM * nN, gid = wgid / nig, fm = gid * WGM, gsz = (nM - fm) < WGM ? (nM - fm) : WGM;
        u.pm = fm + ((wgid % nig) % gsz); u.pn = (wgid % nig) / gsz; u.ko = 0; return true;
    }
    __device__ __forceinline__ void a_ready(const Unit&) const {}
    __device__ __forceinline__ void done(const Unit&) const {}
    __device__ __forceinline__ void warm(const Unit&, const char*, size_t, PG8_LAS unsigned char*, int) const {}
};
__device__ __forceinline__ unsigned cvt_pk_bf16(float lo, float hi) { unsigned r; asm volatile("v_cvt_pk_bf16_f32 %0, %1, %2" : "=v"(r) : "v"(lo), "v"(hi)); return r; }
typedef float f32x2 __attribute__((ext_vector_type(2)));
template <class Epi, class Sched, bool ALIGN_EPI = false, bool SP2 = false>
__device__ __forceinline__ void gemm_phase(PG8_LAS unsigned char* lds, const Gemm g, const Sched& S, const Epi& E) {
    int tid = threadIdx.x; asm volatile("" : "+v"(tid));
    const int wid = __builtin_amdgcn_readfirstlane(tid >> 6), lane = tid & 63, wr = wid >> 2, wc = wid & 3, fr = lane & 15, fq = lane >> 4;
    const int K = g.K, nt = K / BK, LD = g.ld;
    constexpr bool GATHER = Sched::GATHER;
    static_assert(!GATHER || SP2, "the gathered A path is written for the SP2 loop");
    unsigned voffA[2], voffB[2]; int Rl[2], Cl2[2];
#pragma unroll
    for (int i = 0; i < 2; ++i) { int R, C; stage_rc(tid * 16 + i * 8192, R, C); const int Rb = Epi::PERM ? ((R & ~31) + perm32(R & 31)) : R; Rl[i] = R; Cl2[i] = C * 2;
        voffA[i] = (unsigned)(R * LD + C) * 2u; voffB[i] = (unsigned)(Rb * LD + C) * 2u; }
    unsigned gAc[2][2], gAn[2][2], gA2[2][2]; int graw[2][2];
#define PG8_GISSUE(u) do { _Pragma("unroll") for (int _h = 0; _h < 2; ++_h) _Pragma("unroll") for (int _i = 0; _i < 2; ++_i) graw[_h][_i] = g.rowidx[(u).pm * 256 + _h * 128 + Rl[_i]]; } while (0)
#define PG8_GFIN(o) do { _Pragma("unroll") for (int _h = 0; _h < 2; ++_h) _Pragma("unroll") for (int _i = 0; _i < 2; ++_i) (o)[_h][_i] = (unsigned)(graw[_h][_i] < 0 ? 0 : graw[_h][_i]) * (unsigned)(PG8_GATHER_KT_ROWS ? 128 : LD * 2) + (unsigned)Cl2[_i]; } while (0)
#define PG8_GCOPY(d, s) do { _Pragma("unroll") for (int _h = 0; _h < 2; ++_h) _Pragma("unroll") for (int _i = 0; _i < 2; ++_i) (d)[_h][_i] = (s)[_h][_i]; } while (0)
    const size_t kstep = (size_t)(BK * 2);
    constexpr bool PF = Sched::PF && !GATHER;
    const unsigned voffP = (unsigned)(((wid & 3) * 64 + lane) * LD) * 2u;
#define PG8_PF(pa, pb) do { if constexpr (PF) __builtin_amdgcn_global_load_lds((const unsigned*)(((wid < 4) ? (pa) : (pb)) + voffP), (PG8_LAS unsigned*)(lds + STAGE_BYTES + 512), 4, 0, 0); } while (0)
#define PG8_WAIT_VP() do { if constexpr (PF) PG8_WAIT_V(9); else PG8_WAIT_V(8); } while (0)
    const size_t kstepA = (GATHER && PG8_GATHER_KT_ROWS) ? (size_t)PG8_GATHER_KT_ROWS * 128 : kstep;
    const size_t hstep = (size_t)HALF * LD * 2;
    const size_t tstep = 2 * hstep;
    const unsigned ldsw = (unsigned)wid * 1024u;
    const int aoff = lds_byte(wr * 64 + fr, fq * 8), boff = lds_byte(wc * 32 + fr, fq * 8);
#define PG8_SA(b, h) (((b) * 2 + (h)) * HTB)
#define PG8_SB(b, h) ((4 + (b) * 2 + (h)) * HTB)
#define PG8_STAGE(bufoff, gbase, voff) do { _Pragma("unroll") for (int _i = 0; _i < 2; ++_i) \
        __builtin_amdgcn_global_load_lds((const unsigned*)((const char*)(gbase) + (voff)[_i]), (PG8_LAS unsigned*)(lds + (bufoff) + ldsw + _i * 8192), 16, 0, ((bufoff) >= 4 * HTB) ? Sched::AUX_B : 0); } while (0)
#define PG8_LDA(dst, b, h) do { _Pragma("unroll") for (int m = 0; m < 4; ++m) _Pragma("unroll") for (int k = 0; k < 2; ++k) dst[m][k] = *(const PG8_LAS bf16x8*)(lds + PG8_SA(b, h) + aoff + m * 2048 + k * 1024); } while (0)
#define PG8_LDB(dst, b, h) do { _Pragma("unroll") for (int n = 0; n < 2; ++n) _Pragma("unroll") for (int k = 0; k < 2; ++k) dst[n][k] = *(const PG8_LAS bf16x8*)(lds + PG8_SB(b, h) + boff + n * 2048 + k * 1024); } while (0)
#define PG8_MMA(ai, bj, At, Bt) do { __builtin_amdgcn_s_setprio(1); _Pragma("unroll") for (int m = 0; m < 4; ++m) _Pragma("unroll") for (int n = 0; n < 2; ++n) _Pragma("unroll") for (int k = 0; k < 2; ++k) \
        acc[ai][bj][m][n] = __builtin_amdgcn_mfma_f32_16x16x32_bf16(Bt[n][k], At[m][k], acc[ai][bj][m][n], 0, 0, 0); __builtin_amdgcn_s_setprio(0); } while (0)
#define PG8_WAIT_V(n) asm volatile("s_waitcnt vmcnt(" #n ")" ::: "memory")
#define PG8_WAIT_L(n) asm volatile("s_waitcnt lgkmcnt(" #n ")" ::: "memory")
#define PG8_BAR __builtin_amdgcn_s_barrier()
#define PG8_SCHED __builtin_amdgcn_sched_barrier(0)
    Unit cur, nxt; int ui = 0;
    if (!S.next(0, cur)) return;
    f32x4 acc[2][2][4][2];
#pragma unroll
    for (int a = 0; a < 2; ++a)
#pragma unroll
        for (int b = 0; b < 2; ++b)
#pragma unroll
            for (int m = 0; m < 4; ++m)
#pragma unroll
                for (int n = 0; n < 2; ++n) acc[a][b][m][n] = (f32x4){0.f, 0.f, 0.f, 0.f};
    bf16x8 At[4][2], B0[2][2], B1[2][2];
    const char* cA = (const char*)g.A + (GATHER ? (size_t)0 : (size_t)cur.pm * tstep) + (size_t)cur.ko * 2; const char* cB = (const char*)g.Bt + (size_t)cur.pn * tstep + (size_t)cur.ko * 2;
    S.a_ready(cur);
    if constexpr (GATHER) { PG8_GISSUE(cur); PG8_GFIN(gAc); Unit n1; if (S.next(1, n1)) { PG8_GISSUE(n1); PG8_GFIN(gAn); } else PG8_GCOPY(gAn, gAc); PG8_GCOPY(gA2, gAn); }
#define PG8_STAGE_A(bufoff, kptr, h, offs) do { if constexpr (GATHER) PG8_STAGE(bufoff, kptr, (offs)[h]); else PG8_STAGE(bufoff, (kptr) + (h) * hstep, voffA); } while (0)
    if constexpr (SP2) {
        PG8_STAGE(PG8_SB(0, 0), cB, voffB); PG8_STAGE(PG8_SB(0, 1), cB + hstep, voffB); PG8_STAGE_A(PG8_SA(0, 0), cA, 0, gAc); PG8_STAGE_A(PG8_SA(0, 1), cA, 1, gAc);
        if (wr == 1) PG8_BAR;
        PG8_WAIT_V(2); PG8_BAR;
        PG8_STAGE(PG8_SB(1, 0), cB + kstep, voffB); PG8_STAGE_A(PG8_SA(1, 0), cA + kstepA, 0, gAc); PG8_STAGE(PG8_SB(1, 1), cB + hstep + kstep, voffB);
        PG8_WAIT_V(6); PG8_BAR;
    } else {
        PG8_STAGE(PG8_SB(0, 0), cB, voffB); PG8_STAGE(PG8_SA(0, 0), cA, voffA); PG8_STAGE(PG8_SB(0, 1), cB + hstep, voffB); PG8_STAGE(PG8_SA(0, 1), cA + hstep, voffA);
        if (wr == 1) PG8_BAR;
        PG8_WAIT_V(4); PG8_BAR;
        PG8_STAGE(PG8_SB(1, 0), cB + kstep, voffB); PG8_STAGE(PG8_SA(1, 0), cA + kstep, voffA); PG8_STAGE(PG8_SB(1, 1), cB + hstep + kstep, voffB);
        PG8_WAIT_V(6); PG8_BAR;
    }
    for (;;) {
        const bool has_next = S.next(ui + 1, nxt);
        const bool hm = cur.pm >= Sched::HALF_PM;
        const char* nA = has_next ? (const char*)g.A + (GATHER ? (size_t)0 : (size_t)nxt.pm * tstep) + (size_t)nxt.ko * 2 : cA; const char* nB = has_next ? (const char*)g.Bt + (size_t)nxt.pn * tstep + (size_t)nxt.ko * 2 : cB;
        for (int t = 0; t < nt; t += 2) {
            const bool last = (t == nt - 2);
            const char* a1 = cA + (size_t)(t + 1) * kstepA;
            const char* a2 = last ? nA : cA + (size_t)(t + 2) * kstepA; const char* b2 = last ? nB : cB + (size_t)(t + 2) * kstep;
            const char* a3 = a2 + kstepA; const char* b3 = b2 + kstep;
            const char* pa3 = (t + 3 < nt) ? cA + (size_t)(t + 3) * kstepA : nA + (size_t)(t + 3 - nt) * kstepA; const char* pb3 = (t + 3 < nt) ? cB + (size_t)(t + 3) * kstep : nB + (size_t)(t + 3 - nt) * kstep;
            const char* pa4 = (t + 4 < nt) ? cA + (size_t)(t + 4) * kstepA : nA + (size_t)(t + 4 - nt) * kstepA; const char* pb4 = (t + 4 < nt) ? cB + (size_t)(t + 4) * kstep : nB + (size_t)(t + 4 - nt) * kstep;
            if (last && has_next) S.a_ready(nxt);
            unsigned o2[2][2];
            if constexpr (GATHER) { _Pragma("unroll") for (int _h = 0; _h < 2; ++_h) _Pragma("unroll") for (int _i = 0; _i < 2; ++_i) o2[_h][_i] = last ? gAn[_h][_i] : gAc[_h][_i]; }
            if constexpr (SP2) {
            PG8_LDB(B0, 0, 0); PG8_LDB(B1, 0, 1); PG8_SCHED; PG8_LDA(At, 0, 0); PG8_STAGE_A(PG8_SA(1, 1), a1, 1, gAc);
            PG8_WAIT_VP(); PG8_WAIT_L(0); PG8_BAR; PG8_MMA(0, 0, At, B0); PG8_MMA(0, 1, At, B1); PG8_BAR; PG8_SCHED;
            PG8_LDA(At, 0, 1); PG8_STAGE(PG8_SB(0, 0), b2, voffB); PG8_STAGE(PG8_SB(0, 1), b2 + hstep, voffB); PG8_STAGE_A(PG8_SA(0, 0), a2, 0, o2); PG8_PF(pa3, pb3);
            PG8_WAIT_VP(); PG8_WAIT_L(0); PG8_BAR; if (!hm) { PG8_MMA(1, 0, At, B0); PG8_MMA(1, 1, At, B1); } PG8_BAR; PG8_SCHED;
            PG8_LDB(B0, 1, 0); PG8_LDB(B1, 1, 1); PG8_SCHED; PG8_LDA(At, 1, 0); PG8_STAGE_A(PG8_SA(0, 1), a2, 1, o2);
            PG8_WAIT_VP(); PG8_WAIT_L(0); PG8_BAR; PG8_MMA(0, 0, At, B0); PG8_MMA(0, 1, At, B1); PG8_BAR; PG8_SCHED;
            PG8_LDA(At, 1, 1); PG8_STAGE(PG8_SB(1, 0), b3, voffB); PG8_STAGE(PG8_SB(1, 1), b3 + hstep, voffB); PG8_STAGE_A(PG8_SA(1, 0), a3, 0, o2); PG8_PF(pa4, pb4);
            PG8_WAIT_VP(); PG8_WAIT_L(0); PG8_BAR; if (!hm) { PG8_MMA(1, 0, At, B0); PG8_MMA(1, 1, At, B1); } PG8_BAR; PG8_SCHED;
            } else {
            PG8_LDB(B0, 0, 0); PG8_SCHED; PG8_LDA(At, 0, 0); PG8_STAGE(PG8_SA(1, 1), a1 + hstep, voffA);
            PG8_WAIT_L(8); PG8_BAR; PG8_WAIT_L(0); PG8_MMA(0, 0, At, B0); PG8_BAR; PG8_SCHED;
            PG8_LDB(B1, 0, 1); PG8_STAGE(PG8_SB(0, 0), b2, voffB);
            PG8_BAR; PG8_WAIT_L(0); PG8_MMA(0, 1, At, B1); PG8_BAR;
            PG8_LDA(At, 0, 1); PG8_STAGE(PG8_SA(0, 0), a2, voffA);
            PG8_BAR; PG8_WAIT_L(0); PG8_MMA(1, 0, At, B0); PG8_BAR; PG8_SCHED;
            PG8_STAGE(PG8_SB(0, 1), b2 + hstep, voffB);
            PG8_WAIT_V(6); PG8_BAR; PG8_MMA(1, 1, At, B1); PG8_BAR;
            PG8_LDB(B0, 1, 0); PG8_SCHED; PG8_LDA(At, 1, 0); PG8_STAGE(PG8_SA(0, 1), a2 + hstep, voffA);
            PG8_WAIT_L(8); PG8_BAR; PG8_WAIT_L(0); PG8_MMA(0, 0, At, B0); PG8_BAR; PG8_SCHED;
            PG8_LDB(B1, 1, 1); PG8_STAGE(PG8_SB(1, 0), b3, voffB);
            PG8_BAR; PG8_WAIT_L(0); PG8_MMA(0, 1, At, B1); PG8_BAR;
            PG8_LDA(At, 1, 1); PG8_STAGE(PG8_SA(1, 0), a3, voffA);
            PG8_BAR; PG8_WAIT_L(0); PG8_MMA(1, 0, At, B0); PG8_BAR; PG8_SCHED;
            PG8_STAGE(PG8_SB(1, 1), b3 + hstep, voffB);
            PG8_WAIT_V(6); PG8_BAR; PG8_MMA(1, 1, At, B1); PG8_BAR;
            }
        }
        if constexpr (ALIGN_EPI) { if (wr == 0) PG8_BAR; }
        if (has_next) S.warm(nxt, nB, hstep, lds + STAGE_BYTES + 512, tid);
        bool has2 = false; if constexpr (GATHER) { Unit nx2; has2 = has_next && S.next(ui + 2, nx2); if (has2) PG8_GISSUE(nx2); }
        if constexpr (!Epi::AFTER_DRAIN) { E(acc, cur, wr, wc, fr, fq); S.done(cur); }
        if constexpr (GATHER) { if (has2) PG8_GFIN(gA2); else PG8_GCOPY(gA2, gAn); }
        if (!has_next) break;
#pragma unroll
        for (int a = 0; a < 2; ++a)
#pragma unroll
            for (int b = 0; b < 2; ++b)
#pragma unroll
                for (int m = 0; m < 4; ++m)
#pragma unroll
                    for (int n = 0; n < 2; ++n) acc[a][b][m][n] = (f32x4){0.f, 0.f, 0.f, 0.f};
        cur = nxt; cA = nA; cB = nB; ++ui;
        if constexpr (GATHER) { PG8_GCOPY(gAc, gAn); PG8_GCOPY(gAn, gA2); }
        if constexpr (ALIGN_EPI) { if (wr == 1) PG8_BAR; }
    }
    PG8_WAIT_V(0);
    if constexpr (!ALIGN_EPI) { if (wr == 0) PG8_BAR; }
    PG8_BAR;
    if constexpr (Epi::AFTER_DRAIN) { E.fused(acc, cur, wr, wc, fr, fq, lds, wid, lane); S.done(cur); }
#undef PG8_SA
#undef PG8_PF
#undef PG8_WAIT_VP
#undef PG8_STAGE_A
#undef PG8_GISSUE
#undef PG8_GFIN
#undef PG8_GCOPY
#undef PG8_SB
#undef PG8_STAGE
#undef PG8_LDA
#undef PG8_LDB
#undef PG8_MMA
#undef PG8_WAIT_V
#undef PG8_WAIT_L
#undef PG8_BAR
#undef PG8_SCHED
}
}

#ifndef XBF16
#define XBF16 1
#endif
#ifndef MK_SPLIT
#define MK_SPLIT 0
#endif
constexpr int D = 1024, NB = 4, SEQ = 4096, CTXL = 256, DEPTH = 2;
constexpr int MX = NB * SEQ;
constexpr int MC = NB * CTXL;
constexpr int MALL = MX + MC;
constexpr int NPROJ = 2048;
constexpr int DFF = 2816, NE = 16, CAPX = 512, CAPC = 32;
constexpr int SLOTX = NE * NB * CAPX;
constexpr int SLOTALL = SLOTX + NE * 256;
constexpr int NCHUNK = 68;
constexpr int NPH = 22;

constexpr size_t MiB = 1u << 20;
constexpr size_t WS_CTL = 0, CTL_ZERO_BYTES = 64 * 1024;
constexpr size_t WS_MOD = 1 * MiB;
constexpr size_t WS_PE = WS_MOD + 256 * 1024;
constexpr size_t WS_M1 = WS_PE + 128 * 1024;
constexpr size_t WS_M3 = WS_M1 + 32768;
constexpr size_t WS_GWT = 2 * MiB;
constexpr size_t WS_MCT = 2 * MiB + 512 * 1024;
constexpr size_t WS_SUMM = 3 * MiB;
constexpr size_t WS_AFF = 6 * MiB;
constexpr size_t WS_TOKSLOT = 8 * MiB;
constexpr size_t WS_SELTOK = 10 * MiB;
constexpr size_t WS_SELG = 10 * MiB + 256 * 1024;
constexpr size_t WS_WIN = 12 * MiB;
constexpr size_t WS_WOUT = 20 * MiB;
constexpr size_t WS_BT1 = 24 * MiB;
constexpr size_t WS_BT2 = 376 * MiB;
constexpr size_t WS_XRES = 552 * MiB;
constexpr size_t WS_HN = 620 * MiB;
constexpr size_t WS_VX = 654 * MiB;
constexpr size_t WS_VC = 686 * MiB;
constexpr size_t WS_UX = 688 * MiB;
constexpr size_t WS_UG = 705 * MiB;
constexpr size_t WS_MIX = 722 * MiB;
constexpr size_t WS_XG = 756 * MiB;
constexpr size_t WS_HID = 828 * MiB;
constexpr size_t WS_YS = 1026 * MiB;
constexpr size_t WS_YS2 = 1098 * MiB;
constexpr size_t WS_END = 1106 * MiB;
constexpr int CW_BAR = 1024;

constexpr int RING_BYTES = 131072;
constexpr int MISC_OFF = RING_BYTES;
constexpr int LDS_BYTES = RING_BYTES + 1024;

#define LAS __attribute__((address_space(3)))
typedef unsigned short bf16;
typedef float f32x4 __attribute__((ext_vector_type(4)));
typedef float f32x2 __attribute__((ext_vector_type(2)));
typedef float f32x16 __attribute__((ext_vector_type(16)));
typedef short bf16x8 __attribute__((ext_vector_type(8)));
typedef unsigned u32x4 __attribute__((ext_vector_type(4)));
typedef unsigned u32x2 __attribute__((ext_vector_type(2)));

__device__ __forceinline__ unsigned pk2(float lo, float hi) { return pg8::cvt_pk_bf16(lo, hi); }
__device__ __forceinline__ float bflo(unsigned u) { return __builtin_bit_cast(float, u << 16); }
__device__ __forceinline__ float bfhi(unsigned u) { return __builtin_bit_cast(float, u & 0xffff0000u); }
__device__ __forceinline__ unsigned short f2bf1(float f) { return (unsigned short)(pk2(f, 0.f) & 0xffffu); }
__device__ __forceinline__ float wave_sum(float v) {
#pragma unroll
    for (int o = 1; o < 64; o <<= 1) v += __shfl_xor(v, o);
    return v;
}

#define XB_TMO      128
#define XB_XCNT(j)  (256  + 64 * (j))
#define XB_XSUB(j)  (1280 + 64 * (j))
#define XB_XGEN(j)  (2304 + 64 * (j))
#define XB_TOP      3328
#define XB_TOPGEN   3392
#define XCD_BAR_WORDS 3456
#define XB_SPIN_CAP (1u << 18)
__device__ __forceinline__ unsigned xb_ld(unsigned* p)              { return __hip_atomic_load(p, __ATOMIC_RELAXED, __HIP_MEMORY_SCOPE_AGENT); }
__device__ __forceinline__ unsigned xb_add(unsigned* p, unsigned v) { return __hip_atomic_fetch_add(p, v, __ATOMIC_RELAXED, __HIP_MEMORY_SCOPE_AGENT); }
__device__ __forceinline__ unsigned xb_xcc_id() { return (unsigned)__builtin_amdgcn_s_getreg((3 << 11) | 20) & 0xFu; }
#define XB_SPIN(cond, bar) do { unsigned _sp = 0; while (cond) { __builtin_amdgcn_s_sleep(1); \
    if ((++_sp & 255u) == 0u) { if (xb_ld(&(bar)[XB_TMO])) break; if (_sp > XB_SPIN_CAP) { atomicAdd(&(bar)[XB_TMO], 1u); break; } } } } while (0)
struct XcdBarrier { unsigned* bar; unsigned x; volatile LAS unsigned* st; };
__device__ __forceinline__ XcdBarrier xcd_barrier_post(unsigned* bar, volatile LAS unsigned* st) {
    XcdBarrier b; b.bar = bar; b.x = xb_xcc_id(); b.st = st;
    if (threadIdx.x == 0) (void)xb_add(&bar[XB_XCNT(b.x)], 1u);
    return b;
}
__device__ __forceinline__ void xcd_barrier_complete(unsigned* bar, unsigned x, unsigned& nloc, unsigned& nx) {
    const unsigned G = gridDim.x * gridDim.y * gridDim.z;
    unsigned sum, cnt, mine, sp = 0u;
    for (;;) {
        sum = 0u; cnt = 0u; mine = 0u;
#pragma unroll
        for (unsigned j = 0; j < 16; ++j) { const unsigned c = xb_ld(&bar[XB_XCNT(j)]); sum += c; cnt += (c > 0u) ? 1u : 0u; mine = (j == x) ? c : mine; }
        if (sum == G) break;
        __builtin_amdgcn_s_sleep(1);
        if ((++sp & 255u) == 0u) { if (xb_ld(&bar[XB_TMO])) break; if (sp > XB_SPIN_CAP) { atomicAdd(&bar[XB_TMO], 1u); break; } }
    }
    nloc = mine > 0u ? mine : 1u; nx = cnt > 0u ? cnt : 1u;
}
__device__ __forceinline__ void xcd_barrier(const XcdBarrier& b) {
    asm volatile("s_waitcnt vmcnt(0)" ::: "memory");
    __syncthreads();
    if (threadIdx.x == 0) {
        unsigned* bar = b.bar;
        __builtin_amdgcn_s_waitcnt(0);
        unsigned nloc = b.st[0], nx = b.st[1];
        if (nloc == 0u) { xcd_barrier_complete(bar, b.x, nloc, nx); b.st[0] = nloc; b.st[1] = nx; }
        const unsigned old = xb_add(&bar[XB_XSUB(b.x)], 1u);
        const unsigned gen = old / nloc;
        if (old + 1u == (gen + 1u) * nloc) {
            __builtin_amdgcn_fence(__ATOMIC_RELEASE, "agent");
            asm volatile("s_waitcnt vmcnt(0)" ::: "memory");
            const unsigned og = xb_add(&bar[XB_TOP], 1u);
            const unsigned tg = og / nx;
            if (og + 1u == (tg + 1u) * nx) xb_add(&bar[XB_TOPGEN], 1u);
            else XB_SPIN(xb_ld(&bar[XB_TOPGEN]) == tg, bar);
            __builtin_amdgcn_fence(__ATOMIC_ACQUIRE, "agent");
            xb_add(&bar[XB_XGEN(b.x)], 1u);
            asm volatile("s_waitcnt vmcnt(0)" ::: "memory");
        } else {
            XB_SPIN(xb_ld(&bar[XB_XGEN(b.x)]) == gen, bar);
            __builtin_amdgcn_fence(__ATOMIC_ACQUIRE, "agent");
            asm volatile("s_waitcnt vmcnt(0)" ::: "memory");
        }
    }
    __syncthreads();
}

__device__ __forceinline__ void tr_load(const float* W, int ldn, int kbase, int nbase, int lane, f32x4 (&v)[8]) {
    const int k0 = (lane >> 3) * 8, n0 = (lane & 7) * 4;
    const float* src = W + (size_t)(kbase + k0) * ldn + nbase + n0;
#pragma unroll
    for (int i = 0; i < 8; ++i) v[i] = __builtin_nontemporal_load((const f32x4*)(src + (size_t)i * ldn));
}
__device__ __forceinline__ void tr_store(const f32x4 (&v)[8], bf16* WT, int K, int kbase, int drow0, int lane) {
    const int k0 = (lane >> 3) * 8, n0 = (lane & 7) * 4;
#pragma unroll
    for (int j = 0; j < 4; ++j) {
        u32x4 o; o.x = pk2(v[0][j], v[1][j]); o.y = pk2(v[2][j], v[3][j]); o.z = pk2(v[4][j], v[5][j]); o.w = pk2(v[6][j], v[7][j]);
        __builtin_nontemporal_store(o, (u32x4*)(WT + (size_t)(drow0 + n0 + j) * K + kbase + k0));
    }
}
__device__ __forceinline__ void tr_item(const float* W, int K, int ldn, int kbase, int nbase, bf16* WT, int drow0, int lane) {
    f32x4 v[8]; tr_load(W, ldn, kbase, nbase, lane, v); tr_store(v, WT, K, kbase, drow0, lane);
}
struct DownItem { const float* src; bf16* dst; int kbase, nbase; };
__device__ __forceinline__ DownItem down_item(const float* w_down, bf16* BT2, int it) {
    const int le = it / 1408, r = it % 1408; DownItem d; d.src = w_down + (size_t)le * DFF * 1024; d.dst = BT2 + (size_t)le * 1024 * DFF; d.kbase = (r >> 5) * 64; d.nbase = (r & 31) * 32; return d;
}
struct GuItem { size_t soff; bf16* dst; int kbase, nbase, drow0; };
__device__ __forceinline__ GuItem gu_item(bf16* BT1, int it) {
    const int le = it / 1408, r = it % 1408, kb = r / 88, nb = r % 88; GuItem g; g.soff = (size_t)le * 1024 * DFF; g.dst = BT1 + (size_t)le * 5632 * 1024; g.kbase = kb * 64; g.nbase = nb * 32;
    g.drow0 = (g.nbase >> 7) * 256 + (g.nbase & 127); return g;
}
struct ConvCtx { const float *wg, *wu, *wd; bf16 *BT1, *BT2; int layer, pass, nA, bgu0; };
struct CItem { const float* src; bf16* dst; int ldn, Kd, kbase, nbase, drow0; };
__device__ __forceinline__ CItem citem_gu(const ConvCtx& c, int sgl) {
    const int up = sgl >= 16 * 1408, it = up ? sgl - 16 * 1408 : sgl;
    const GuItem g = gu_item(c.BT1, c.layer * 16 * 1408 + it);
    CItem r; r.src = (up ? c.wu : c.wg) + g.soff; r.dst = g.dst; r.ldn = DFF; r.Kd = 1024; r.kbase = g.kbase; r.nbase = g.nbase; r.drow0 = g.drow0 + (up ? 128 : 0); return r;
}
__device__ __forceinline__ CItem citem_down(const ConvCtx& c, int it) {
    const DownItem d = down_item(c.wd, c.BT2, c.layer * 16 * 1408 + it);
    CItem r; r.src = d.src; r.dst = d.dst; r.ldn = 1024; r.Kd = DFF; r.kbase = d.kbase; r.nbase = d.nbase; r.drow0 = d.nbase; return r;
}
constexpr int CV_SLOTS = 256 * 9 * 8;
constexpr int TQ_PROJ = 5, TQ_OUT = 6, TQ_G1 = 5, TQ_G2 = 8;
constexpr int NT_PROJ = 224 * 8 * TQ_PROJ, NT_OUT = 240 * 8 * TQ_OUT, NT_G1 = 160 * 8 * TQ_G1, NT_G2 = 128 * 8 * TQ_G2;
#ifndef NG_PROJ0
#define NG_PROJ0 184
#endif
#ifndef NG_OUT0
#define NG_OUT0 136
#endif
#ifndef TQ_PROJ0
#define TQ_PROJ0 20
#endif
#ifndef TQ_OUT0
#define TQ_OUT0 10
#endif
constexpr int NT_PROJ0 = (256 - NG_PROJ0) * 8 * TQ_PROJ0, NT_OUT0 = (256 - NG_OUT0) * 8 * TQ_OUT0;
constexpr int NTAIL_L0 = NT_PROJ0 + NT_OUT0, NTAIL_L1 = NT_G1 + NT_G2 + NT_PROJ;
__device__ __forceinline__ bool conv_pick(const ConvCtx& c, int slot, int which, CItem& it) {
    if (c.pass == 0) { if (which != 0 || slot >= c.nA) return false; it = citem_gu(c, slot); return true; }
    if (which == 0) { it = citem_down(c, slot); return true; }
    if (slot % 3 >= 2) return false;
    const int j = (slot / 3) * 2 + slot % 3;
    if (j < 4096) { it = citem_down(c, CV_SLOTS + j); return true; }
    if (c.bgu0 + j - 4096 >= 32 * 1408) return false;
    it = citem_gu(c, c.bgu0 + j - 4096);
    return true;
}
constexpr int CV_FOUR = 8192;
__device__ __forceinline__ int cv_nA(int l) { return l == 0 ? 45056 - CV_FOUR - NTAIL_L0 : 13312; }

__device__ __forceinline__ void conv_tail(const ConvCtx& c, int first, int r, int nidle, int Q, int lane, int wv) {
    f32x4 va[8], vb[8]; CItem ia, ib;
    ia = citem_gu(c, first + r * 8 + wv); tr_load(ia.src, ia.ldn, ia.kbase, ia.nbase, lane, va);
    for (int q = 0; q < Q; q += 2) {
        const bool hb = q + 1 < Q;
        if (hb) { ib = citem_gu(c, first + ((q + 1) * nidle + r) * 8 + wv); tr_load(ib.src, ib.ldn, ib.kbase, ib.nbase, lane, vb); }
        tr_store(va, ia.dst, ia.Kd, ia.kbase, ia.drow0, lane);
        if (q + 2 < Q) { ia = citem_gu(c, first + ((q + 2) * nidle + r) * 8 + wv); tr_load(ia.src, ia.ldn, ia.kbase, ia.nbase, lane, va); }
        if (hb) tr_store(vb, ib.dst, ib.Kd, ib.kbase, ib.drow0, lane);
    }
}

#ifndef G1_AUX_B
#define G1_AUX_B 0
#endif
#ifndef EXPERT_AUX_B
#define EXPERT_AUX_B 0
#endif
#ifndef G1_MG
#define G1_MG 2
#endif
#ifndef G1_SEQ
#define G1_SEQ 0
#endif
#ifndef WARM_B
#define WARM_B 0
#endif
#ifndef HALF_CTX
#define HALF_CTX 1
#endif
template <bool GATHER_> struct GroupedOrderT {
    static constexpr bool GATHER = GATHER_; static constexpr int AUX_B = GATHER_ ? G1_AUX_B : EXPERT_AUX_B, HALF_PM = HALF_CTX ? 128 : (1 << 30); static constexpr bool PF = PG8_PREFETCH;
    int TN, MT, nwg, G, c, nlines, erev, seq, mg;
    __device__ void init(int TN_, int MT_, int G_, int c_, int nlines_, int erev_ = 0, int seq_ = 0, int mg_ = 0) { TN = TN_; MT = MT_; nwg = NE * TN * MT; G = G_; c = c_; nlines = nlines_; erev = erev_; seq = seq_; mg = mg_; }
    __device__ bool next(int i, pg8::Unit& u) const {
        const long L = (long)i * G + c; if (L >= nwg) return false;
        const int q = nwg / 8, xcd = (int)(L % 8);
        int off = (int)(L / 8);
        if (seq) {
            const int r = c / 8, nr = G / 8, base = q / nr, rem = q % nr;
            if (i >= base + (r < rem ? 1 : 0)) return false;
            off = r * base + (r < rem ? r : rem) + i;
        }
        int mt, j, e;
        if (mg) {
            const int PE = TN * MT, el = off / PE, o = off % PE, nb = TN * mg, ngrp = 8 / mg;
            if (o < nb * ngrp) { const int h = o / nb, r = o % nb; j = r / mg; mt = h * mg + r % mg; }
            else { j = o - nb * ngrp; mt = 8; }
            e = (xcd * 2 + el) ^ erev;
        } else { const int W = xcd * q + off; mt = W % MT; const int rest = W / MT; j = rest % TN; e = (rest / TN) ^ erev; }
        u.pm = (mt < 8) ? e * 8 + mt : 128 + e; u.pn = e * TN + j; u.ko = 0; return true;
    }
    __device__ __forceinline__ void a_ready(const pg8::Unit&) const {}
    __device__ __forceinline__ void done(const pg8::Unit&) const {}
    __device__ __forceinline__ void warm(const pg8::Unit& n, const char* nB, size_t hstep, LAS unsigned char* dummy, int tid) const {
#if WARM_B
        if (!(n.pm < 128 && (n.pm & 7) == 0)) return;
        const char* rowp = nB + (size_t)(tid >> 1) * (hstep >> 7);
        for (int ln = 2 + (tid & 1); ln < nlines; ln += 2) __builtin_amdgcn_global_load_lds((const unsigned*)(rowp + ln * 128), (LAS unsigned*)dummy, 4, 0, 0);
#endif
    }
};
typedef GroupedOrderT<false> GroupedOrder; typedef GroupedOrderT<true> GroupedGatherOrder;
struct CtxSplitOrder {
    static constexpr bool GATHER = false; static constexpr int AUX_B = 0, HALF_PM = HALF_CTX ? 128 : (1 << 30); static constexpr bool PF = PG8_PREFETCH;
    int G, c, KH;
    __device__ void init(int G_, int c_, int KH_) { G = G_; c = c_; KH = KH_; }
    __device__ bool next(int i, pg8::Unit& u) const {
        const int W = i * G + c; if (W >= NE * 4 * 2) return false;
        const int ks = W & 1, jn = (W >> 1) & 3, e = W >> 3;
        u.pm = 128 + e; u.pn = e * 4 + jn; u.ko = ks * KH; return true;
    }
    __device__ __forceinline__ void a_ready(const pg8::Unit&) const {}
    __device__ __forceinline__ void done(const pg8::Unit&) const {}
    __device__ __forceinline__ void warm(const pg8::Unit&, const char*, size_t, LAS unsigned char*, int) const {}
};

struct EpiProj {
    static constexpr bool PERM = true, AFTER_DRAIN = false;
    bf16 *VX, *VC, *UX, *UG;
    __device__ __forceinline__ void operator()(const f32x4 (&acc)[2][2][4][2], const pg8::Unit& u, int wr, int wc, int fr, int fq) const {
        const int rl0 = wr * 64 + fr, cl0 = wc * 32 + 8 * fq;
        if (u.pn >= 4) {
            bf16* base = ((u.pn < 6) ? UX : UG) + (size_t)(u.pm * 256 + rl0) * 512 + (u.pn & 1) * 256 + cl0;
#pragma unroll
            for (int ai = 0; ai < 2; ++ai)
#pragma unroll
                for (int m = 0; m < 4; ++m)
#pragma unroll
                    for (int bj = 0; bj < 2; ++bj) {
                        const f32x4 v0 = acc[ai][bj][m][0], v1 = acc[ai][bj][m][1];
                        *(u32x4*)(base + (size_t)(ai * 128 + m * 16) * 512 + bj * 128) = (u32x4){pk2(v0[0], v0[1]), pk2(v0[2], v0[3]), pk2(v1[0], v1[1]), pk2(v1[2], v1[3])};
                    }
        } else if (u.pm < 64) {
            const int ri = u.pn >> 1, b = u.pm >> 4, t0 = (u.pm & 15) * 256 + rl0, cb0 = ((u.pn & 1) * 256 + cl0) >> 2;
            bf16* base = VX + ((size_t)((b * 128 + cb0) * 2 + ri) * 4096 + t0) * 4;
#pragma unroll
            for (int ai = 0; ai < 2; ++ai)
#pragma unroll
                for (int m = 0; m < 4; ++m)
#pragma unroll
                    for (int bj = 0; bj < 2; ++bj) {
                        const f32x4 v0 = acc[ai][bj][m][0], v1 = acc[ai][bj][m][1];
                        bf16* p = base + (size_t)(bj * 32) * 2 * 4096 * 4 + (size_t)(ai * 128 + m * 16) * 4;
                        *(u32x2*)p = (u32x2){pk2(v0[0], v0[1]), pk2(v0[2], v0[3])};
                        *(u32x2*)(p + (size_t)2 * 4096 * 4) = (u32x2){pk2(v1[0], v1[1]), pk2(v1[2], v1[3])};
                    }
        } else {
            const int ri = u.pn >> 1, rc0 = (u.pm - 64) * 256 + rl0;
            bf16* base = VC + ((size_t)(ri * 512 + (u.pn & 1) * 256 + cl0)) * 256;
#pragma unroll
            for (int ai = 0; ai < 2; ++ai)
#pragma unroll
                for (int m = 0; m < 4; ++m) {
                    const int rc = rc0 + ai * 128 + m * 16, b = rc >> 8, t = rc & 255;
#pragma unroll
                    for (int bj = 0; bj < 2; ++bj) {
                        bf16* p = base + (size_t)(b * 2 * 512 + bj * 128) * 256 + t;
#pragma unroll
                        for (int n = 0; n < 2; ++n)
#pragma unroll
                            for (int i = 0; i < 4; ++i) p[(4 * n + i) * 256] = f2bf1(acc[ai][bj][m][n][i]);
                    }
                }
        }
    }
};
#if XBF16
struct EpiOut {
    static constexpr bool PERM = true, AFTER_DRAIN = false;
    bf16* X; const float* modl; float gs;
    __device__ __forceinline__ void operator()(const f32x4 (&acc)[2][2][4][2], const pg8::Unit& u, int wr, int wc, int fr, int fq) const {
        const int brow = (u.pm < 64) ? (u.pm >> 4) : 4;
        const int col0 = u.pn * 256 + wc * 32 + 8 * fq;
        const float* gp = modl + brow * 6144 + 2048 + col0;
        f32x4 gv[2][2];
#pragma unroll
        for (int bj = 0; bj < 2; ++bj)
#pragma unroll
            for (int n = 0; n < 2; ++n) gv[bj][n] = *(const f32x4*)(gp + bj * 128 + n * 4) * gs;
#pragma unroll
        for (int ai = 0; ai < 2; ++ai)
#pragma unroll
            for (int m = 0; m < 4; ++m) {
                bf16* rowp = X + (size_t)(u.pm * 256 + ai * 128 + wr * 64 + m * 16 + fr) * 1024 + col0;
#pragma unroll
                for (int bj = 0; bj < 2; ++bj) {
                    u32x4* p = (u32x4*)(rowp + bj * 128); const u32x4 xv = *p;
                    const f32x4 x0 = (f32x4){bflo(xv.x), bfhi(xv.x), bflo(xv.y), bfhi(xv.y)} + gv[bj][0] * acc[ai][bj][m][0];
                    const f32x4 x1 = (f32x4){bflo(xv.z), bfhi(xv.z), bflo(xv.w), bfhi(xv.w)} + gv[bj][1] * acc[ai][bj][m][1];
                    *p = (u32x4){pk2(x0[0], x0[1]), pk2(x0[2], x0[3]), pk2(x1[0], x1[1]), pk2(x1[2], x1[3])};
                }
            }
    }
};
#else
struct EpiOut {
    static constexpr bool PERM = false, AFTER_DRAIN = false;
    float* X; const float* modl; float gs;
    __device__ __forceinline__ void operator()(const f32x4 (&acc)[2][2][4][2], const pg8::Unit& u, int wr, int wc, int fr, int fq) const {
        const int brow = (u.pm < 64) ? (u.pm >> 4) : 4;
        const int col0 = u.pn * 256 + wc * 32 + 4 * fq;
        const float* gp = modl + brow * 6144 + 2048 + col0;
        f32x4 gv[2][2];
#pragma unroll
        for (int bj = 0; bj < 2; ++bj)
#pragma unroll
            for (int n = 0; n < 2; ++n) gv[bj][n] = *(const f32x4*)(gp + bj * 128 + n * 16) * gs;
#pragma unroll
        for (int ai = 0; ai < 2; ++ai)
#pragma unroll
            for (int m = 0; m < 4; ++m) {
                float* rowp = X + (size_t)(u.pm * 256 + ai * 128 + wr * 64 + m * 16 + fr) * 1024 + col0;
#pragma unroll
                for (int bj = 0; bj < 2; ++bj)
#pragma unroll
                    for (int n = 0; n < 2; ++n) { f32x4* p = (f32x4*)(rowp + bj * 128 + n * 16); const f32x4 xv = *p; *p = xv + gv[bj][n] * acc[ai][bj][m][n]; }
            }
    }
};
#endif
struct EpiG1 {
    static constexpr bool PERM = true, AFTER_DRAIN = false;
    bf16* HID; int TN;
    __device__ __forceinline__ void operator()(const f32x4 (&acc)[2][2][4][2], const pg8::Unit& u, int wr, int wc, int fr, int fq) const {
        const int col0 = (u.pn % TN) * 128 + wc * 32 + 8 * fq;
#pragma unroll
        for (int ai = 0; ai < 2; ++ai) { if (HALF_CTX && ai == 1 && u.pm >= 128) break;
#pragma unroll
            for (int m = 0; m < 4; ++m) {
                const int row = u.pm * 256 + ai * 128 + wr * 64 + m * 16 + fr;
                float h[8];
#pragma unroll
                for (int n = 0; n < 2; ++n)
#pragma unroll
                    for (int i = 0; i < 4; ++i) { const float g = acc[ai][0][m][n][i], up = acc[ai][1][m][n][i]; h[n * 4 + i] = g * up * __builtin_amdgcn_rcpf(1.0f + __builtin_amdgcn_exp2f(-1.4426950408889634f * g)); }
                *(u32x4*)(HID + (size_t)row * DFF + col0) = (u32x4){pk2(h[0], h[1]), pk2(h[2], h[3]), pk2(h[4], h[5]), pk2(h[6], h[7])};
            }
        }
    }
};
struct EpiG2 {
    static constexpr bool PERM = true, AFTER_DRAIN = false;
    bf16* YS; bf16* YS2; const float* SELG;
    __device__ __forceinline__ void operator()(const f32x4 (&acc)[2][2][4][2], const pg8::Unit& u, int wr, int wc, int fr, int fq) const {
        const int col0 = (u.pn & 3) * 256 + wc * 32 + 8 * fq;
        bf16* base = (u.ko == 0) ? YS : YS2 - (size_t)SLOTX * 1024;
#pragma unroll
        for (int ai = 0; ai < 2; ++ai) { if (HALF_CTX && ai == 1 && u.pm >= 128) break;
#pragma unroll
            for (int m = 0; m < 4; ++m) {
                const int row = u.pm * 256 + ai * 128 + wr * 64 + m * 16 + fr;
                const float g = SELG[row];
#pragma unroll
                for (int bj = 0; bj < 2; ++bj) {
                    const f32x4 v0 = acc[ai][bj][m][0] * g, v1 = acc[ai][bj][m][1] * g;
                    u32x4 w; w.x = pk2(v0[0], v0[1]); w.y = pk2(v0[2], v0[3]); w.z = pk2(v1[0], v1[1]); w.w = pk2(v1[2], v1[3]);
                    *(u32x4*)(base + (size_t)row * 1024 + col0 + bj * 128) = w;
                }
            }
        }
    }
};

typedef float f32x16 __attribute__((ext_vector_type(16)));
__device__ __forceinline__ void fold_item(const float* w_in_l, bf16* win_l, int kb, int g, int it, unsigned char* lds, int tid) {
    float* Wl = (float*)lds;
    float* tc = Wl + 32 * 129;
    float* tn = tc + 128;
    for (int i = tid; i < 1024; i += 512) { const int kk = i >> 5, c4 = (i & 31) * 4; const f32x4 v = *(const f32x4*)(w_in_l + (size_t)(kb * 64 + it * 32 + kk) * 1536 + g * 128 + c4);
        float* d = Wl + kk * 129 + c4; d[0] = v[0]; d[1] = v[1]; d[2] = v[2]; d[3] = v[3]; }
    if (tid < 128) { float s, c; sincospif((float)tid * (1.0f / 64.0f), &s, &c); tc[tid] = c * 0.08838834764831845f; tn[tid] = -s * 0.08838834764831845f; }
    __syncthreads();
    const int w = tid >> 6, lane = tid & 63, j = lane & 31, h = lane >> 5, cp = (32 * w + j) & 127;
    const float* tab = (w >> 2) ? tn : tc;
    const float* wrow = Wl + j * 129 + h;
    f32x16 acc;
#pragma unroll
    for (int r = 0; r < 16; ++r) acc[r] = 0.f;
    int idx = (h * cp) & 127;
#pragma unroll 8
    for (int s = 0; s < 64; ++s) {
        acc = __builtin_amdgcn_mfma_f32_32x32x2f32(wrow[2 * s], tab[idx], acc, 0, 0, 0);
        idx = (idx + 2 * cp) & 127;
    }
    bf16* dst = win_l + (size_t)((w >> 2) * 512 + g * 128 + cp) * 1024 + kb * 64 + it * 32 + 4 * h;
#pragma unroll
    for (int q = 0; q < 4; ++q) *(u32x2*)(dst + 8 * q) = (u32x2){pk2(acc[4 * q], acc[4 * q + 1]), pk2(acc[4 * q + 2], acc[4 * q + 3])};
    __syncthreads();
}
__device__ __forceinline__ void mod_item(const float* c_in, const float* cctx, const float* w_mod_l, const float* b_mod_l, float* mod_l, int jb, unsigned char* lds, int tid) {
    float* cond = (float*)lds;
    float* red = (float*)(lds + 20480);
    for (int i = tid; i < 5120; i += 512) { const float v = (i < 4096) ? c_in[i] : cctx[i - 4096]; cond[i] = v / (1.0f + expf(-v)); }
    __syncthreads();
    const int jq = tid & 15, kq = tid >> 4;
    f32x4 acc[5];
#pragma unroll
    for (int r = 0; r < 5; ++r) acc[r] = (f32x4){0.f, 0.f, 0.f, 0.f};
    const float* wp = w_mod_l + (size_t)(kq * 32) * 6144 + jb * 64 + jq * 4;
#pragma unroll 16
    for (int k = 0; k < 32; ++k) {
        const f32x4 w = __builtin_nontemporal_load((const f32x4*)(wp + (size_t)k * 6144));
#pragma unroll
        for (int r = 0; r < 5; ++r) acc[r] += w * cond[r * 1024 + kq * 32 + k];
    }
#pragma unroll
    for (int r = 0; r < 5; ++r) *(f32x4*)(red + ((kq * 5 + r) * 64 + jq * 4)) = acc[r];
    __syncthreads();
    if (tid < 320) { const int r = tid >> 6, col = tid & 63; float s = 0.f;
        for (int k2 = 0; k2 < 32; ++k2) s += red[(k2 * 5 + r) * 64 + col];
        mod_l[r * 6144 + jb * 64 + col] = s + b_mod_l[jb * 64 + col]; }
    __syncthreads();
}
__device__ __forceinline__ void tables_items(unsigned char* ws, const float* lru_wa, const float* lru_wi, int gi, int gn) {
    bf16* M1 = (bf16*)(ws + WS_M1); bf16* M3 = (bf16*)(ws + WS_M3); float* PE = (float*)(ws + WS_PE); bf16* GWT = (bf16*)(ws + WS_GWT);
    for (int idx = gi; idx < 128 * 128; idx += gn) {
        const int R = idx >> 7, Cc = idx & 127, ro = R >> 6, k1 = R & 63, ri = Cc >> 6, n1 = Cc & 63, mm = (n1 * k1) & 63;
        float s, c; sincospif((float)mm * (1.0f / 32.0f), &s, &c);
        const float v = (ro == ri) ? c : (ro == 0 ? s : -s);
        M1[idx] = f2bf1(v * 0.125f);
    }
    for (int idx = gi; idx < 64 * 128; idx += gn) {
        const int k2 = idx >> 7, Cc = idx & 127, ri = Cc >> 6, n2 = Cc & 63, mm = (n2 * k2) & 63;
        float s, c; sincospif((float)mm * (1.0f / 32.0f), &s, &c);
        M3[idx] = f2bf1((ri == 0 ? c : s) * 0.125f);
    }
    { bf16* MCT = (bf16*)(ws + WS_MCT);
      for (int idx = gi; idx < 256 * 512; idx += gn) {
        const int k = idx >> 9, Cc = idx & 511, ri = Cc >> 8, n = Cc & 255, mm = (n * k) & 255;
        float sn, cs; sincospif((float)mm * (1.0f / 128.0f), &sn, &cs);
        MCT[idx] = f2bf1((ri == 0 ? cs : sn) * 0.0625f);
      } }
    for (int idx = gi; idx < 64 * 512; idx += gn) {
        const int p = idx >> 9, j = idx & 511, jj = j & 255;
        const float om = 1.0f / powf(10000.0f, (float)jj * (1.0f / 256.0f));
        const float ang = (float)p * om;
        PE[idx] = (j < 256) ? sinf(ang) : cosf(ang);
    }
    for (int idx = gi; idx < 2 * 2 * 2 * 8 * 4096; idx += gn) {
        const int i = idx & 63, j = (idx >> 6) & 63, hd = (idx >> 12) & 7, mat = (idx >> 15) & 1, dir = (idx >> 16) & 1, l = idx >> 17;
        const float* src = mat ? lru_wi : lru_wa;
        GWT[idx] = f2bf1(src[((size_t)((l * 2 + dir) * 8 + hd) * 64 + i) * 64 + j]);
    }
}

__device__ __forceinline__ void row_store_bf16(bf16* dst, const f32x4 (&v)[4], int lane) {
#pragma unroll
    for (int j = 0; j < 4; ++j) *(u32x2*)(dst + 4 * lane + 256 * j) = (u32x2){pk2(v[j][0], v[j][1]), pk2(v[j][2], v[j][3])};
}
__device__ __forceinline__ void row_store_bf16_kt(bf16* dst, const f32x4 (&v)[4], int lane) {
#pragma unroll
    for (int j = 0; j < 4; ++j) *(u32x2*)(dst + (size_t)((lane >> 4) + 4 * j) * ((size_t)PG8_GATHER_KT_ROWS * 64) + 4 * (lane & 15)) = (u32x2){pk2(v[j][0], v[j][1]), pk2(v[j][2], v[j][3])};
}
constexpr int HNRS = PG8_GATHER_KT_ROWS ? 64 : 1024;
#if XBF16
typedef bf16 xres_t;
__device__ __forceinline__ void xrow_load(const xres_t* p, int lane, f32x4 (&v)[4]) {
#pragma unroll
    for (int j = 0; j < 4; ++j) { const u32x2 d = __builtin_nontemporal_load((const u32x2*)(p + 4 * lane + 256 * j)); v[j] = (f32x4){bflo(d.x), bfhi(d.x), bflo(d.y), bfhi(d.y)}; }
}
__device__ __forceinline__ void xrow_store(xres_t* p, int lane, const f32x4 (&v)[4]) { row_store_bf16(p, v, lane); }
#else
typedef float xres_t;
__device__ __forceinline__ void xrow_load(const xres_t* p, int lane, f32x4 (&v)[4]) {
#pragma unroll
    for (int j = 0; j < 4; ++j) v[j] = *(const f32x4*)(p + 4 * lane + 256 * j);
}
__device__ __forceinline__ void xrow_store(xres_t* p, int lane, const f32x4 (&v)[4]) {
#pragma unroll
    for (int j = 0; j < 4; ++j) *(f32x4*)(p + 4 * lane + 256 * j) = v[j];
}
#endif
__device__ __forceinline__ float row_rstd(const f32x4 (&v)[4]) {
    float ss = 0.f;
#pragma unroll
    for (int j = 0; j < 4; ++j) ss += (v[j][0] * v[j][0] + v[j][1] * v[j][1]) + (v[j][2] * v[j][2] + v[j][3] * v[j][3]);
    ss = wave_sum(ss);
    return 1.0f / sqrtf(ss * (1.0f / 1024.0f) + 1e-6f);
}
__device__ __forceinline__ void load_modAB(const float* gain, const float* modl, int r, int osh, int osc, int lane, f32x4 (&A)[4], f32x4 (&Bv)[4]) {
#pragma unroll
    for (int j = 0; j < 4; ++j) {
        const int c = 4 * lane + 256 * j;
        const f32x4 g = *(const f32x4*)(gain + c), sc = *(const f32x4*)(modl + r * 6144 + osc + c);
        A[j] = g * (sc + 1.0f); Bv[j] = *(const f32x4*)(modl + r * 6144 + osh + c);
    }
}

__device__ __forceinline__ int xz_addr(int ri, int a, int ch, int i) { return (ri * 64 + a) * 528 + ch * 128 + i * 2; }
__device__ __forceinline__ void fourier_unit(const bf16* VX, const bf16* M1g, const bf16* M3g, bf16* MIX, int b, int cb, const ConvCtx cc, int cslot, LAS unsigned char* lds, int tid) {
    const int lane = tid & 63, wv = tid >> 6;
    f32x4 cv[8]; CItem ci = citem_gu(cc, cc.nA + (cslot * 8 + wv) * 2);
    tr_load(ci.src, ci.ldn, ci.kbase, ci.nbase, lane, cv);
    LAS unsigned char* RA = lds;
    LAS unsigned char* RB = lds + 67584;
    for (int ri = 0; ri < 2; ++ri) {
        const bf16* src = VX + ((size_t)((b * 128 + cb) * 2 + ri) * 4096) * 4;
#pragma unroll
        for (int it = 0; it < 4; ++it) {
            const int p = tid + 512 * it;
            const u32x4 d = __builtin_nontemporal_load((const u32x4*)(src + (size_t)p * 8));
            const int n1 = p >> 5, n2 = (2 * p) & 63;
            LAS unsigned char* q = RB + (n1 * 65 + n2) * 8;
            *(LAS u32x2*)q = (u32x2){d.x, d.y}; *(LAS u32x2*)(q + 8) = (u32x2){d.z, d.w};
        }
        __syncthreads();
#pragma unroll
        for (int it = 0; it < 8; ++it) {
            const int n2 = wv + 8 * it;
            const u32x2 d = *(LAS u32x2*)(RB + (lane * 65 + n2) * 8);
            *(LAS unsigned short*)(RA + xz_addr(ri, n2, 0, lane)) = (unsigned short)(d.x & 0xffffu);
            *(LAS unsigned short*)(RA + xz_addr(ri, n2, 1, lane)) = (unsigned short)(d.x >> 16);
            *(LAS unsigned short*)(RA + xz_addr(ri, n2, 2, lane)) = (unsigned short)(d.y & 0xffffu);
            *(LAS unsigned short*)(RA + xz_addr(ri, n2, 3, lane)) = (unsigned short)(d.y >> 16);
        }
        __syncthreads();
    }
    tr_store(cv, ci.dst, ci.Kd, ci.kbase, ci.drow0, lane);
    for (int i = tid; i < 2048; i += 512) *(LAS u32x4*)(RB + (i >> 4) * 272 + (i & 15) * 16) = *(const u32x4*)(M1g + (size_t)i * 8);
    for (int i = tid; i < 1024; i += 512) *(LAS u32x4*)(RB + 34816 + (i >> 4) * 272 + (i & 15) * 16) = *(const u32x4*)(M3g + (size_t)i * 8);
    __syncthreads();
    const int ch = wv >> 1, nb2 = 32 * (wv & 1), c32 = lane & 31, h = lane >> 5;
    f32x16 acc[4];
#pragma unroll
    for (int mt = 0; mt < 4; ++mt)
#pragma unroll
        for (int r = 0; r < 16; ++r) acc[mt][r] = 0.f;
#pragma unroll
    for (int s = 0; s < 8; ++s) {
        const bf16x8 bfr = *(LAS bf16x8*)(RA + xz_addr(s >> 2, nb2 + c32, ch, 16 * (s & 3) + 8 * h));
#pragma unroll
        for (int mt = 0; mt < 4; ++mt) {
            const bf16x8 afr = *(LAS bf16x8*)(RB + (32 * mt + c32) * 272 + (16 * s + 8 * h) * 2);
            acc[mt] = __builtin_amdgcn_mfma_f32_32x32x16_bf16(afr, bfr, acc[mt], 0, 0, 0);
        }
    }
    __syncthreads();
    {
        const int n2 = nb2 + c32;
        float w1s, w1c, w8s, w8c, w32s, w32c, s0s, s0c;
        sincospif((float)n2 * (1.0f / 2048.0f), &w1s, &w1c);
        sincospif((float)((8 * n2) & 4095) * (1.0f / 2048.0f), &w8s, &w8c);
        sincospif((float)((32 * n2) & 4095) * (1.0f / 2048.0f), &w32s, &w32c);
        sincospif((float)((4 * h * n2) & 4095) * (1.0f / 2048.0f), &s0s, &s0c);
        float bc = s0c, bs = s0s;
#pragma unroll
        for (int mt = 0; mt < 2; ++mt) {
            float ic = bc, is = bs;
#pragma unroll
            for (int i = 0; i < 4; ++i) {
                float jc = ic, js = is;
#pragma unroll
                for (int j = 0; j < 4; ++j) {
                    const int r = 4 * i + j, k1 = 32 * mt + j + 8 * i + 4 * h;
                    const float ar = acc[mt][r], ai = acc[mt + 2][r];
                    const float zr = ar * jc + ai * js, zi = ai * jc - ar * js;
                    *(LAS unsigned short*)(RA + xz_addr(0, k1, ch, n2)) = f2bf1(zr);
                    *(LAS unsigned short*)(RA + xz_addr(1, k1, ch, n2)) = f2bf1(zi);
                    const float tc_ = jc * w1c - js * w1s, ts_ = js * w1c + jc * w1s; jc = tc_; js = ts_;
                }
                const float tc_ = ic * w8c - is * w8s, ts_ = is * w8c + ic * w8s; ic = tc_; is = ts_;
            }
            const float tc_ = bc * w32c - bs * w32s, ts_ = bs * w32c + bc * w32s; bc = tc_; bs = ts_;
        }
    }
    __syncthreads();
    ci = citem_gu(cc, cc.nA + (cslot * 8 + wv) * 2 + 1);
    tr_load(ci.src, ci.ldn, ci.kbase, ci.nbase, lane, cv);
    f32x16 a3[2];
#pragma unroll
    for (int mt = 0; mt < 2; ++mt)
#pragma unroll
        for (int r = 0; r < 16; ++r) a3[mt][r] = 0.f;
    {
        const int k1 = nb2 + c32;
#pragma unroll
        for (int s = 0; s < 8; ++s) {
            const bf16x8 bfr = *(LAS bf16x8*)(RA + xz_addr(s >> 2, k1, ch, 16 * (s & 3) + 8 * h));
#pragma unroll
            for (int mt = 0; mt < 2; ++mt) {
                const bf16x8 afr = *(LAS bf16x8*)(RB + 34816 + (32 * mt + c32) * 272 + (16 * s + 8 * h) * 2);
                a3[mt] = __builtin_amdgcn_mfma_f32_32x32x16_bf16(afr, bfr, a3[mt], 0, 0, 0);
            }
        }
        __syncthreads();
#pragma unroll
        for (int mt = 0; mt < 2; ++mt)
#pragma unroll
            for (int r = 0; r < 16; ++r) {
                const int k2 = 32 * mt + (r & 3) + 8 * (r >> 2) + 4 * h, tok = k1 + 64 * k2;
                *(LAS unsigned short*)(RA + (tok * 4 + ch) * 2) = f2bf1(a3[mt][r]);
            }
    }
    __syncthreads();
#pragma unroll
    for (int it = 0; it < 8; ++it) {
        const int tok = tid + 512 * it;
        *(u32x2*)(MIX + (size_t)(b * 4096 + tok) * 1024 + cb * 4) = *(LAS u32x2*)(RA + tok * 8);
    }
    tr_store(cv, ci.dst, ci.Kd, ci.kbase, ci.drow0, lane);
    __syncthreads();
}
__device__ __forceinline__ void fourier_ctx_unit(const bf16* VCt, const bf16* MCT, bf16* MIX, int b, int cb, int tid) {
    const int lane = tid & 63, wv = tid >> 6, c32 = lane & 31, h = lane >> 5;
    f32x16 acc;
#pragma unroll
    for (int r = 0; r < 16; ++r) acc[r] = 0.f;
    const bf16* ap = MCT + (size_t)(32 * wv + c32) * 512 + 8 * h;
    const bf16* bp = VCt + ((size_t)(b * 2) * 512 + cb * 32 + c32) * 256 + 8 * h;
#pragma unroll 8
    for (int s = 0; s < 32; ++s) {
        const int kidx = 16 * s, ri = kidx >> 8, n = kidx & 255;
        const bf16x8 afr = *(const bf16x8*)(ap + kidx);
        const bf16x8 bfr = *(const bf16x8*)(bp + (size_t)ri * 512 * 256 + n);
        acc = __builtin_amdgcn_mfma_f32_32x32x16_bf16(afr, bfr, acc, 0, 0, 0);
    }
#pragma unroll
    for (int r = 0; r < 16; ++r) {
        const int k = 32 * wv + (r & 3) + 8 * (r >> 2) + 4 * h;
        MIX[(size_t)(MX + b * 256 + k) * 1024 + cb * 32 + c32] = f2bf1(acc[r]);
    }
}

__device__ __forceinline__ float fexp2(float x) { return __builtin_amdgcn_exp2f(x); }
__device__ __forceinline__ float frcp(float x) { return __builtin_amdgcn_rcpf(x); }
__device__ __forceinline__ float fsigmoid(float x) { return frcp(1.0f + fexp2(-1.4426950408889634f * x)); }
__device__ __forceinline__ void scan_unit_geom(int p, int& s, int& qc, int& nset, int& rowbase, int& t0) {
    s = p / NCHUNK; qc = p % NCHUNK;
    nset = (qc < 4) ? 256 : 4096; rowbase = (qc < 4) ? MX + s * 256 : s * 4096; t0 = (qc < 4) ? qc * 64 : (qc - 4) * 64;
}
__device__ __forceinline__ void scan_load_raw(const bf16* UX, int p, int hd, int tt, int c8, u32x4 (&raw)[4]) {
    int s, qc, nset, rowbase, t0; scan_unit_geom(p, s, qc, nset, rowbase, t0);
#pragma unroll
    for (int k = 0; k < 4; ++k) {
        const int t = t0 + tt - 1 + k;
        raw[k] = (u32x4){0u, 0u, 0u, 0u};
        if (t >= 0 && t < nset) raw[k] = *(const u32x4*)(UX + (size_t)(rowbase + t) * 512 + hd * 64 + c8);
    }
}
template <bool FINAL>
__device__ __forceinline__ void scan_phase(const bf16* UX, const bf16* UG, bf16* MIX, const bf16* GWT, float* SUMM, const float* conv_w_l, const float* conv_b_l,
                                           const float* ba_l, const float* bi_l, const float* lam_l, int l, int w, bool skip_ctx, const ConvCtx cc, LAS unsigned char* lds, int tid) {
    const int lane = tid & 63, wv = tid >> 6, dir = wv >> 2, cg = wv & 3, hd = w >> 5;
    const int fr = lane & 15, q = lane >> 4;
    LAS float* XC32 = (LAS float*)lds;
    LAS unsigned char* XCb = lds + 16640;
    LAS float* Y = (LAS float*)(lds + 16640 + 9216);
    bf16x8 bfr[2][2];
#pragma unroll
    for (int mat = 0; mat < 2; ++mat)
#pragma unroll
        for (int ks = 0; ks < 2; ++ks) bfr[mat][ks] = *(const bf16x8*)(GWT + (size_t)((((l * 2 + dir) * 2 + mat) * 8 + hd) * 64 + 16 * cg + fr) * 64 + 32 * ks + 8 * q);
    const int chn = hd * 64 + 16 * cg + fr;
    const float ba_ = ba_l[dir * 512 + chn], bi_ = bi_l[dir * 512 + chn];
    const float cl2 = -8.0f * log1pf(expf(-lam_l[dir * 512 + chn])) * 1.4426950408889634f;
    const int tt = tid >> 3, c8 = (tid & 7) * 8;
    LAS float* CW = (LAS float*)(lds + 16640 + 9216 + 33280);
    if (tid < 320) CW[tid] = (tid < 256) ? conv_w_l[(tid >> 6) * 512 + hd * 64 + (tid & 63)] : conv_b_l[hd * 64 + (tid - 256)];
    __syncthreads();
    const int pstep = 32, pend = NB * NCHUNK;
    int p = (w & 31);
    if (skip_ctx) while (p < pend && (p % NCHUNK) < 4) p += pstep;
    u32x4 raw[4];
    if (p < pend) scan_load_raw(UX, p, hd, tt, c8, raw);
    int iter = 0;
    f32x4 cvA[8], cvB[8]; CItem ciA, ciB; bool onA = false, onB = false;
    while (p < pend) {
        int s, qc, nset, rowbase, t0; scan_unit_geom(p, s, qc, nset, rowbase, t0);
        if (onA) tr_store(cvA, ciA.dst, ciA.Kd, ciA.kbase, ciA.drow0, lane);
        if (onB) tr_store(cvB, ciB.dst, ciB.Kd, ciB.kbase, ciB.drow0, lane);
        int pn = p + pstep;
        if (skip_ctx) while (pn < pend && (pn % NCHUNK) < 4) pn += pstep;
        __syncthreads();
        {
            float x[8];
            { const f32x4 b0 = *(LAS f32x4*)(CW + 256 + c8), b1 = *(LAS f32x4*)(CW + 256 + c8 + 4);
#pragma unroll
              for (int i = 0; i < 4; ++i) { x[i] = b0[i]; x[4 + i] = b1[i]; } }
#pragma unroll
            for (int k = 0; k < 4; ++k) {
                const unsigned rw[4] = {raw[k].x, raw[k].y, raw[k].z, raw[k].w};
                const f32x4 w0 = *(LAS f32x4*)(CW + k * 64 + c8), w1 = *(LAS f32x4*)(CW + k * 64 + c8 + 4);
#pragma unroll
                for (int i = 0; i < 8; ++i) x[i] += ((i < 4) ? w0[i & 3] : w1[i & 3]) * ((i & 1) ? bfhi(rw[i >> 1]) : bflo(rw[i >> 1]));
            }
#pragma unroll
            for (int i = 0; i < 8; ++i) XC32[tt * 65 + c8 + i] = x[i];
            *(LAS u32x4*)(XCb + tt * 144 + c8 * 2) = (u32x4){pk2(x[0], x[1]), pk2(x[2], x[3]), pk2(x[4], x[5]), pk2(x[6], x[7])};
        }
        u32x4 ugv = (u32x4){0u, 0u, 0u, 0u};
        if (FINAL) ugv = __builtin_nontemporal_load((const u32x4*)(UG + (size_t)(rowbase + t0 + tt) * 512 + hd * 64 + c8));
        if (pn < pend) scan_load_raw(UX, pn, hd, tt, c8, raw);
        { const int slot = (iter * 256 + w) * 8 + wv; ++iter;
          onA = conv_pick(cc, slot, 0, ciA); if (onA) tr_load(ciA.src, ciA.ldn, ciA.kbase, ciA.nbase, lane, cvA);
          onB = conv_pick(cc, slot, 1, ciB); if (onB) tr_load(ciB.src, ciB.ldn, ciB.kbase, ciB.nbase, lane, cvB); }
        __syncthreads();
        f32x4 ga[4], gi4[4];
#pragma unroll
        for (int m = 0; m < 4; ++m) {
            ga[m] = (f32x4){0.f, 0.f, 0.f, 0.f}; gi4[m] = (f32x4){0.f, 0.f, 0.f, 0.f};
            const int tokA = 16 * (fr >> 2) + 4 * m + (fr & 3);
#pragma unroll
            for (int ks = 0; ks < 2; ++ks) {
                const bf16x8 afr = *(LAS bf16x8*)(XCb + tokA * 144 + (32 * ks + 8 * q) * 2);
                ga[m] = __builtin_amdgcn_mfma_f32_16x16x32_bf16(afr, bfr[0][ks], ga[m], 0, 0, 0);
                gi4[m] = __builtin_amdgcn_mfma_f32_16x16x32_bf16(afr, bfr[1][ks], gi4[m], 0, 0, 0);
            }
        }
        float av[16], dv[16];
#pragma unroll
        for (int m = 0; m < 4; ++m)
#pragma unroll
            for (int j = 0; j < 4; ++j) {
                const int tau = 4 * m + j, T = 16 * q + tau;
                const float r = fsigmoid(ga[m][j] + ba_);
                const float gg = fsigmoid(gi4[m][j] + bi_);
                const float a = fexp2(cl2 * r);
                const float xcv = XC32[T * 65 + 16 * cg + fr];
                av[tau] = a; dv[tau] = __builtin_amdgcn_sqrtf(fmaxf(fmaf(-a, a, 1.0f), 0.f)) * gg * xcv;
            }
        float P = 1.f, H = 0.f;
        if (dir == 0) {
#pragma unroll
            for (int tau = 0; tau < 16; ++tau) { H = av[tau] * H + dv[tau]; P *= av[tau]; }
        } else {
#pragma unroll
            for (int tau = 15; tau >= 0; --tau) { H = av[tau] * H + dv[tau]; P *= av[tau]; }
        }
        float Pq[4], Hq[4];
#pragma unroll
        for (int qq = 0; qq < 4; ++qq) { Pq[qq] = __shfl(P, fr + 16 * qq); Hq[qq] = __shfl(H, fr + 16 * qq); }
        if (!FINAL) {
            float A = 1.f, Hc = 0.f;
            if (dir == 0) {
#pragma unroll
                for (int qq = 0; qq < 4; ++qq) { Hc = Pq[qq] * Hc + Hq[qq]; A *= Pq[qq]; }
            } else {
#pragma unroll
                for (int qq = 3; qq >= 0; --qq) { Hc = Pq[qq] * Hc + Hq[qq]; A *= Pq[qq]; }
            }
            if (q == 0) *(f32x2*)(SUMM + ((size_t)((s * NCHUNK + qc) * 2 + dir) * 512 + chn) * 2) = (f32x2){A, Hc};
        } else {
            const int nctx = (dir == 0) ? 0 : ((qc < 4) ? 3 - qc : 4);
            const int L = (dir == 0) ? qc : ((qc < 4) ? 3 - qc : 4 + (NCHUNK - 1 - qc));
            const int Lq = (L + 3) >> 2, pos0 = q * Lq, pos1 = min(L, pos0 + Lq);
            const float* sb = SUMM + ((size_t)(s * NCHUNK) * 2 + dir) * 512 * 2 + chn * 2;
            float FA = 1.f, FH = 0.f;
            for (int pos = pos0; pos < pos1; pos += 4) {
                f32x2 ah[4];
#pragma unroll
                for (int i = 0; i < 4; ++i) {
                    const int pp = pos + i; ah[i] = (f32x2){1.f, 0.f};
                    if (pp < pos1) { const int c = (dir == 0) ? pp : (pp < nctx ? 3 - pp : (NCHUNK - 1) - (pp - nctx)); ah[i] = *(const f32x2*)(sb + (size_t)c * 2048); }
                }
#pragma unroll
                for (int i = 0; i < 4; ++i) { FH = ah[i][0] * FH + ah[i][1]; FA *= ah[i][0]; }
            }
            float C = 0.f;
#pragma unroll
            for (int g = 0; g < 4; ++g) { const float ga_ = __shfl(FA, fr + 16 * g), gh_ = __shfl(FH, fr + 16 * g); C = ga_ * C + gh_; }
            float h = C;
            if (dir == 0) {
#pragma unroll
                for (int qq = 0; qq < 3; ++qq) if (qq < q) h = Pq[qq] * h + Hq[qq];
#pragma unroll
                for (int tau = 0; tau < 16; ++tau) { h = av[tau] * h + dv[tau]; Y[(16 * q + tau) * 65 + 16 * cg + fr] = h; }
            } else {
#pragma unroll
                for (int qq = 3; qq >= 1; --qq) if (qq > q) h = Pq[qq] * h + Hq[qq];
#pragma unroll
                for (int tau = 15; tau >= 0; --tau) { h = av[tau] * h + dv[tau]; Y[64 * 65 + (16 * q + tau) * 65 + 16 * cg + fr] = h; }
            }
            __syncthreads();
            const size_t row = (size_t)(rowbase + t0 + tt);
            const unsigned ugw[4] = {ugv.x, ugv.y, ugv.z, ugv.w};
            float o[8];
#pragma unroll
            for (int i = 0; i < 8; ++i) {
                const float x = (i & 1) ? bfhi(ugw[i >> 1]) : bflo(ugw[i >> 1]);
                const float z = 0.7978845608028654f * (x + 0.044715f * x * x * x);
                const float th = 1.0f - 2.0f * frcp(1.0f + fexp2(2.8853900817779268f * z));
                const float yv = Y[tt * 65 + c8 + i] + Y[64 * 65 + tt * 65 + c8 + i];
                o[i] = yv * 0.5f * x * (1.0f + th);
            }
            u32x4 ow; ow.x = pk2(o[0], o[1]); ow.y = pk2(o[2], o[3]); ow.z = pk2(o[4], o[5]); ow.w = pk2(o[6], o[7]);
            *(u32x4*)(MIX + row * 1024 + 512 + hd * 64 + c8) = ow;
        }
        p = pn;
    }
    for (; iter <= 9; ++iter) {
        if (onA) tr_store(cvA, ciA.dst, ciA.Kd, ciA.kbase, ciA.drow0, lane);
        if (onB) tr_store(cvB, ciB.dst, ciB.Kd, ciB.kbase, ciB.drow0, lane);
        onA = false; onB = false;
        if (iter < 9) { const int slot = (iter * 256 + w) * 8 + wv;
          onA = conv_pick(cc, slot, 0, ciA); if (onA) tr_load(ciA.src, ciA.ldn, ciA.kbase, ciA.nbase, lane, cvA);
          onB = conv_pick(cc, slot, 1, ciB); if (onB) tr_load(ciB.src, ciB.ldn, ciB.kbase, ciB.nbase, lane, cvB); }
    }
    __syncthreads();
}

__device__ __forceinline__ int wr_addr(int c) { return c * 64 + (c >> 2) * 16; }
template <bool HALF> __device__ __forceinline__ void router_finish(const f32x4 (&lg)[4], float* affrow, int lane) {
    float t8[8], t4[4], t2[2], lgt;
    {
        const bool b0 = lane & 1, b1 = lane & 2, b2 = lane & 4, b3 = lane & 8;
#pragma unroll
        for (int k = 0; k < 8; ++k) { const float keep = b0 ? lg[(2 * k + 1) >> 2][(2 * k + 1) & 3] : lg[(2 * k) >> 2][(2 * k) & 3], send = b0 ? lg[(2 * k) >> 2][(2 * k) & 3] : lg[(2 * k + 1) >> 2][(2 * k + 1) & 3];
            t8[k] = keep + __shfl_xor(send, 1); }
#pragma unroll
        for (int k = 0; k < 4; ++k) { const float keep = b1 ? t8[2 * k + 1] : t8[2 * k], send = b1 ? t8[2 * k] : t8[2 * k + 1]; t4[k] = keep + __shfl_xor(send, 2); }
#pragma unroll
        for (int k = 0; k < 2; ++k) { const float keep = b2 ? t4[2 * k + 1] : t4[2 * k], send = b2 ? t4[2 * k] : t4[2 * k + 1]; t2[k] = keep + __shfl_xor(send, 4); }
        { const float keep = b3 ? t2[1] : t2[0], send = b3 ? t2[0] : t2[1]; lgt = keep + __shfl_xor(send, 8); }
        lgt += __shfl_xor(lgt, 16); if (!HALF) lgt += __shfl_xor(lgt, 32);
    }
    float mx = lgt;
#pragma unroll
    for (int o = 1; o < 16; o <<= 1) mx = fmaxf(mx, __shfl_xor(mx, o));
    const float mine = expf(lgt - mx);
    float sum = mine;
#pragma unroll
    for (int o = 1; o < 16; o <<= 1) sum += __shfl_xor(sum, o);
    if ((lane & 31) < 16) { if (HALF || lane < 16) affrow[lane & 15] = mine / sum; }
}
__device__ __forceinline__ void n2r_prep(const xres_t* x, bf16* h, const f32x4 (&A)[4], const f32x4 (&Bv)[4], int lane, f32x4 (&v)[4]) {
    xrow_load(x, lane, v);
    const float rstd = row_rstd(v);
#pragma unroll
    for (int j = 0; j < 4; ++j) v[j] = v[j] * rstd * A[j] + Bv[j];
    if (PG8_GATHER_KT_ROWS) row_store_bf16_kt(h, v, lane); else row_store_bf16(h, v, lane);
}
template <int NR>
__device__ __forceinline__ void norm2_router_rows(const xres_t* x0, bf16* h0, float* aff0, const f32x4 (&A)[4], const f32x4 (&Bv)[4], const unsigned char* WR, int lane) {
    f32x4 va[4], vb[4], la[4], lb[4];
    n2r_prep(x0, h0, A, Bv, lane, va);
    if (NR == 2) n2r_prep(x0 + 1024, h0 + HNRS, A, Bv, lane, vb);
#pragma unroll
    for (int e4 = 0; e4 < 4; ++e4) { la[e4] = (f32x4){0.f, 0.f, 0.f, 0.f}; lb[e4] = (f32x4){0.f, 0.f, 0.f, 0.f}; }
    int zoff = 0;
#pragma unroll
    for (int j = 0; j < 4; ++j)
#pragma unroll
        for (int i = 0; i < 4; ++i) {
            const int c = 4 * lane + 256 * j + i;
            asm volatile("" : "+v"(zoff), "+v"(la[0]));
            const unsigned char* wp = WR + wr_addr(c) + zoff;
#pragma unroll
            for (int e4 = 0; e4 < 4; ++e4) { const f32x4 w = *(const f32x4*)(wp + 16 * e4); la[e4] += w * va[j][i]; if (NR == 2) lb[e4] += w * vb[j][i]; }
        }
    if (NR == 2) {
        const bool hi = lane >= 32;
        f32x4 m[4];
#pragma unroll
        for (int e4 = 0; e4 < 4; ++e4)
#pragma unroll
            for (int i = 0; i < 4; ++i) { const float keep = hi ? lb[e4][i] : la[e4][i], send = hi ? la[e4][i] : lb[e4][i]; m[e4][i] = keep + __shfl_xor(send, 32); }
        router_finish<true>(m, aff0 + (hi ? 16 : 0), lane);
    } else router_finish<false>(la, aff0, lane);
}

__device__ __forceinline__ unsigned block_excl_scan(unsigned v, unsigned* wt, int tid) {
    const int lane = tid & 63, wv = tid >> 6;
    unsigned inc = v;
#pragma unroll
    for (int o = 1; o < 64; o <<= 1) { const unsigned t = __shfl_up(inc, o); if (lane >= o) inc += t; }
    if (lane == 63) wt[wv] = inc;
    __syncthreads();
    unsigned base = 0;
#pragma unroll
    for (int k = 0; k < 8; ++k) if (k < wv) base += wt[k];
    __syncthreads();
    return base + inc - v;
}
__device__ __forceinline__ void topk_unit(int u, const float* AFF, int* SELTOK, float* SELG, int* TOKSLOT, unsigned char* lds, int tid) {
    const bool isctx = u >= 64; const int uu = isctx ? u - 64 : u, b = uu >> 4, e = uu & 15;
    const int n = isctx ? 256 : 4096, rowbase = isctx ? MX + b * 256 : b * 4096;
    const unsigned cap = isctx ? 32u : 512u;
    const int slotbase = isctx ? SLOTX + e * 256 + b * 32 : e * 2048 + b * 512;
    unsigned* hist = (unsigned*)lds; unsigned* sh = hist + 256; unsigned* wt = hist + 272;
    unsigned key[8];
#pragma unroll
    for (int i = 0; i < 8; ++i) { const int t = tid * 8 + i; key[i] = (t < n) ? __builtin_bit_cast(unsigned, AFF[(size_t)(rowbase + t) * 16 + e]) : 0u; }
    unsigned prefix = 0u, krem = cap;
    for (int pass = 0; pass < 4; ++pass) {
        const int shift = 24 - 8 * pass;
        const unsigned hm = (pass == 0) ? 0u : (0xFFFFFFFFu << (shift + 8));
        if (tid < 256) hist[tid] = 0u;
        __syncthreads();
#pragma unroll
        for (int i = 0; i < 8; ++i) { const int t = tid * 8 + i; if (t < n && (key[i] & hm) == (prefix & hm)) atomicAdd(&hist[(key[i] >> shift) & 255u], 1u); }
        __syncthreads();
        if (tid < 256) { unsigned sfx = 0u; for (int d = 255; d > tid; --d) sfx += hist[d]; const unsigned mine = hist[tid];
            if (sfx < krem && sfx + mine >= krem) { sh[0] = (unsigned)tid; sh[1] = krem - sfx; } }
        __syncthreads();
        prefix |= sh[0] << shift; krem = sh[1];
        __syncthreads();
    }
    const unsigned T = prefix;
    unsigned ce = 0u;
#pragma unroll
    for (int i = 0; i < 8; ++i) { const int t = tid * 8 + i; ce += (t < n && key[i] == T) ? 1u : 0u; }
    unsigned eqr = block_excl_scan(ce, wt, tid);
    unsigned selm = 0u, cs = 0u;
#pragma unroll
    for (int i = 0; i < 8; ++i) { const int t = tid * 8 + i;
        if (t < n) { bool sel = key[i] > T; if (key[i] == T) { sel = eqr < krem; ++eqr; } if (sel) { selm |= 1u << i; ++cs; } } }
    unsigned slot = block_excl_scan(cs, wt, tid);
#pragma unroll
    for (int i = 0; i < 8; ++i) { const int t = tid * 8 + i;
        if (t < n) {
            int R = -1;
            if ((selm >> i) & 1u) { R = slotbase + (int)slot; ++slot; SELTOK[R] = rowbase + t; SELG[R] = __builtin_bit_cast(float, key[i]); }
            TOKSLOT[(size_t)(rowbase + t) * 16 + e] = R;
        } }
    if (isctx && b == 0 && tid < 128) { SELTOK[SLOTX + e * 256 + 128 + tid] = -1; SELG[SLOTX + e * 256 + 128 + tid] = 0.f; }
    __syncthreads();
}

template <bool CTX> __device__ __forceinline__ void combine_core(xres_t* xrow, int myR, const bf16* YS, const bf16* YS2, const f32x4 (&G2)[4], int lane, f32x4 (&v)[4], bool wb);
template <bool CTX> __device__ __forceinline__ void combine_row(xres_t* xrow, const int* tsrow, const bf16* YS, const bf16* YS2, const f32x4 (&G2)[4], int lane, f32x4 (&v)[4], bool wb = true) {
    const int myR = (lane < 16) ? tsrow[lane] : -1;
    xrow_load(xrow, lane, v);
    combine_core<CTX>(xrow, myR, YS, YS2, G2, lane, v, wb);
}
template <bool CTX> __device__ __forceinline__ void combine_core(xres_t* xrow, int myR, const bf16* YS, const bf16* YS2, const f32x4 (&G2)[4], int lane, f32x4 (&v)[4], bool wb) {
    f32x4 acc[4];
#pragma unroll
    for (int j = 0; j < 4; ++j) acc[j] = (f32x4){0.f, 0.f, 0.f, 0.f};
    unsigned mask = (unsigned)__ballot(myR >= 0);
    while (mask) {
        int R[4];
#pragma unroll
        for (int q = 0; q < 4; ++q) { R[q] = -1; if (mask) { const int e = __builtin_ctz(mask); R[q] = __builtin_amdgcn_readlane(myR, e); mask &= mask - 1u; } }
        u32x2 d[4][4], d2[4][4];
#pragma unroll
        for (int q = 0; q < 4; ++q) {
#pragma unroll
            for (int j = 0; j < 4; ++j) { d[q][j] = (u32x2){0u, 0u}; d2[q][j] = (u32x2){0u, 0u}; }
            if (R[q] >= 0) {
                const bf16* yr = YS + (size_t)R[q] * 1024 + 4 * lane;
#pragma unroll
                for (int j = 0; j < 4; ++j) d[q][j] = __builtin_nontemporal_load((const u32x2*)(yr + 256 * j));
                if (CTX) { const bf16* y2 = YS2 + (size_t)(R[q] - SLOTX) * 1024 + 4 * lane;
#pragma unroll
                    for (int j = 0; j < 4; ++j) d2[q][j] = *(const u32x2*)(y2 + 256 * j); }
            }
        }
#pragma unroll
        for (int q = 0; q < 4; ++q)
#pragma unroll
            for (int j = 0; j < 4; ++j) { acc[j] += (f32x4){bflo(d[q][j].x), bfhi(d[q][j].x), bflo(d[q][j].y), bfhi(d[q][j].y)};
                if (CTX) acc[j] += (f32x4){bflo(d2[q][j].x), bfhi(d2[q][j].x), bflo(d2[q][j].y), bfhi(d2[q][j].y)}; }
    }
#pragma unroll
    for (int j = 0; j < 4; ++j) v[j] += G2[j] * acc[j];
    if (wb) xrow_store(xrow, lane, v);
}

struct Args { const float* in[22]; float* out; unsigned char* ws; int ph_lo, ph_hi; };
enum { I_X = 0, I_C, I_CTX, I_CCTX, I_WMOD, I_BMOD, I_N1G, I_N2G, I_WIN, I_CONVW, I_CONVB, I_WA, I_BA, I_WI, I_BI, I_LAM, I_WOUT, I_WR, I_WG, I_WU, I_WD, I_FG };

__global__ void __launch_bounds__(512, 2) fwd_kernel(Args args) {
    extern __shared__ __attribute__((aligned(16))) unsigned char lds_raw[];
    LAS unsigned char* lds = (LAS unsigned char*)lds_raw;
    const int G = gridDim.x, bx = blockIdx.x;
    const int vcu = (G % 8 == 0) ? (bx % 8) * (G / 8) + bx / 8 : bx;
    if (threadIdx.x < 64) ((LAS unsigned*)(lds + MISC_OFF))[threadIdx.x] = 0u;
    __syncthreads();
    const int lo = args.ph_lo, hi = args.ph_hi;
    XcdBarrier bar; bar.bar = (unsigned*)(args.ws + WS_CTL) + CW_BAR; bar.x = 0; bar.st = nullptr;
    if (hi - lo > 1) bar = xcd_barrier_post((unsigned*)(args.ws + WS_CTL) + CW_BAR, (volatile LAS unsigned*)(lds + MISC_OFF) + 8);
#ifdef ONLY_SITE
#define IN(k) ((((k) < 2 ? (k) : 2 + ((k) - 2) % 10) == ONLY_SITE) && lo <= (k) && (k) < hi)
#else
#define IN(k) (lo <= (k) && (k) < hi)
#endif
#ifndef DUP_BAR
#define DUP_BAR 0
#endif
#define SEAM(k) do { if (IN(k) && IN((k) + 1)) { xcd_barrier(bar); if (DUP_BAR) xcd_barrier(bar); } } while (0)
#define P_BEGIN int tid = threadIdx.x; asm volatile("" : "+v"(tid)); const int lane = tid & 63, wv = __builtin_amdgcn_readfirstlane(tid >> 6); (void)lane; (void)wv; \
    unsigned char* ws = args.ws; asm volatile("" : "+s"(ws)); const float* const* inp = (const float* const*)__builtin_amdgcn_kernarg_segment_ptr(); asm volatile("" : "+s"(inp)); \
    const int gw = vcu * 8 + wv, NGW = G * 8; (void)gw; (void)NGW;
#define WSP(T, off) ((T*)(ws + (off)))
#ifndef DUP_SITE
#define DUP_SITE -1
#endif
#define DUPLOOP(s_) for (int rep_ = 0; rep_ < ((s_) == DUP_SITE ? 2 : 1); ++rep_)

#ifndef PASSA_STAGGER
#define PASSA_STAGGER 1
#endif
#ifndef PROBE_P0
#define PROBE_P0 0
#endif
#define PRB(n_) for (int prb_ = 0; prb_ < (PROBE_P0 == (n_) ? 2 : 1); ++prb_)
    if (IN(0)) DUPLOOP(0) { P_BEGIN
        bf16* WIN = WSP(bf16, WS_WIN); bf16* WOUT = WSP(bf16, WS_WOUT); float* MOD = WSP(float, WS_MOD);
        PRB(4) { const int l = bx >> 7, kb = (bx >> 3) & 15, g = (bx >> 1) & 3, it = bx & 1; if (bx < 256) fold_item(inp[I_WIN] + (size_t)l * 1024 * 1536, WIN + (size_t)l * 2048 * 1024, kb, g, it, lds_raw, tid); }
        PRB(1) if (bx >= 64) { const int it = bx - 64, l = it / 96, jb = it % 96;
            mod_item(inp[I_C], inp[I_CCTX], inp[I_WMOD] + (size_t)l * 1024 * 6144, inp[I_BMOD] + l * 6144, MOD + l * 5 * 6144, jb, lds_raw, tid); }
        else PRB(2) tables_items(ws, inp[I_WA], inp[I_WI], bx * 512 + tid, 64 * 512);
        PRB(3) for (int it = gw; it < 2 * 512; it += NGW) { const int l = it >> 9, r = it & 511, kb = r >> 5, nb = r & 31;
            tr_item(inp[I_WIN] + (size_t)l * 1024 * 1536, 1024, 1536, kb * 64, 512 + nb * 32, WIN + (size_t)l * 2048 * 1024, 1024 + nb * 32, lane); }
        PRB(3) for (int it = gw; it < 2 * 512; it += NGW) { const int l = it >> 9, r = it & 511, kb = r >> 5, nb = r & 31;
            tr_item(inp[I_WOUT] + (size_t)l * 1024 * 1024, 1024, 1024, kb * 64, nb * 32, WOUT + (size_t)l * 1024 * 1024, nb * 32, lane); }
    }
    SEAM(0);

    if (IN(1)) DUPLOOP(1) { P_BEGIN
        const float* MOD = WSP(float, WS_MOD); const float* PE = WSP(float, WS_PE); xres_t* XRES = WSP(xres_t, WS_XRES); bf16* HN = WSP(bf16, WS_HN);
        const int w = vcu, b = w >> 6;
        f32x4 A[4], Bv[4];
        load_modAB(inp[I_N1G], MOD, b, 0, 1024, lane, A, Bv);
        const float* xin = inp[I_X];
        for (int i = 0; i < 8; ++i) {
            const int row = 64 * w + 8 * wv + i, t = row & 4095, pr = t >> 6, pc = t & 63;
            f32x4 v[4];
#pragma unroll
            for (int j = 0; j < 4; ++j) { const int c = 4 * lane + 256 * j;
                const f32x4 pe = (j < 2) ? *(const f32x4*)(PE + pr * 512 + c) : *(const f32x4*)(PE + pc * 512 + c - 512);
                v[j] = __builtin_nontemporal_load((const f32x4*)(xin + (size_t)row * 1024 + c)) + pe; }
            xrow_store(XRES + (size_t)row * 1024, lane, v);
            const float rstd = row_rstd(v);
#pragma unroll
            for (int j = 0; j < 4; ++j) v[j] = v[j] * rstd * A[j] + Bv[j];
            row_store_bf16(HN + (size_t)row * 1024, v, lane);
        }
        if (wv < 4) {
            load_modAB(inp[I_N1G], MOD, 4, 0, 1024, lane, A, Bv);
            const int cr = 4 * w + wv, row = MX + cr;
            const float* cin = inp[I_CTX];
            f32x4 v[4];
#pragma unroll
            for (int j = 0; j < 4; ++j) { const int c = 4 * lane + 256 * j; v[j] = *(const f32x4*)(cin + (size_t)cr * 1024 + c); }
            xrow_store(XRES + (size_t)row * 1024, lane, v);
            const float rstd = row_rstd(v);
#pragma unroll
            for (int j = 0; j < 4; ++j) v[j] = v[j] * rstd * A[j] + Bv[j];
            row_store_bf16(HN + (size_t)row * 1024, v, lane);
        }
    }
    SEAM(1);

    for (int l = 0; l < DEPTH; ++l) {
        const int pb = 2 + 10 * l;
        const bool last = (l == DEPTH - 1);
        if (IN(pb + 0)) DUPLOOP(2) { P_BEGIN
            const int NGp = (l == 0) ? NG_PROJ0 : G;
            pg8::Gemm g{WSP(bf16, WS_HN), WSP(bf16, WS_WIN) + (size_t)l * 2048 * 1024, MALL, NPROJ, D, D, nullptr}; pg8::StaticOrder S; S.init(MALL, NPROJ, NGp, bx);
            EpiProj E{WSP(bf16, WS_VX), WSP(bf16, WS_VC), WSP(bf16, WS_UX), WSP(bf16, WS_UG)};
            if (bx < NGp) pg8::gemm_phase<EpiProj, pg8::StaticOrder, true, true>(lds, g, S, E);
            const ConvCtx cc{inp[I_WG], inp[I_WU], inp[I_WD], WSP(bf16, WS_BT1), WSP(bf16, WS_BT2), l, 0, 0, 0};
            if (l == 0) { if (bx >= NG_PROJ0) conv_tail(cc, cv_nA(0) + CV_FOUR, bx - NG_PROJ0, 256 - NG_PROJ0, TQ_PROJ0, lane, wv); }
            else if (bx >= 32) conv_tail(cc, cv_nA(l) + CV_FOUR + NT_G1 + NT_G2, bx - 32, 224, TQ_PROJ, lane, wv);
        }
        SEAM(pb + 0);
        if (IN(pb + 1)) DUPLOOP(3) { P_BEGIN
            bf16* MIX = WSP(bf16, WS_MIX);
            const int ord = PASSA_STAGGER ? ((bx >> 3) & 1) : 0;
#define PASSA_FOUR() do { const ConvCtx ccf{inp[I_WG], inp[I_WU], inp[I_WD], WSP(bf16, WS_BT1), WSP(bf16, WS_BT2), l, 0, cv_nA(l), 0}; \
                for (int u = vcu; u < 512; u += G) fourier_unit(WSP(bf16, WS_VX), WSP(bf16, WS_M1), WSP(bf16, WS_M3), MIX, u >> 7, u & 127, ccf, u, lds, tid); \
                if (!last) for (int u = bx; u < 64; u += G) fourier_ctx_unit(WSP(bf16, WS_VC), WSP(bf16, WS_MCT), MIX, u >> 4, u & 15, tid); } while (0)
#define PASSA_SCAN() scan_phase<false>(WSP(bf16, WS_UX), WSP(bf16, WS_UG), MIX, WSP(bf16, WS_GWT), WSP(float, WS_SUMM), inp[I_CONVW] + l * 4 * 512, inp[I_CONVB] + l * 512, inp[I_BA] + l * 1024, inp[I_BI] + l * 1024, \
                                      inp[I_LAM] + l * 1024, l, bx, false, ConvCtx{inp[I_WG], inp[I_WU], inp[I_WD], WSP(bf16, WS_BT1), WSP(bf16, WS_BT2), l, 0, cv_nA(l), 0}, lds, tid)
            if (ord == 0) { PASSA_FOUR(); __syncthreads(); PASSA_SCAN(); } else { PASSA_SCAN(); __syncthreads(); PASSA_FOUR(); }
#undef PASSA_FOUR
#undef PASSA_SCAN
        }
        SEAM(pb + 1);
        if (IN(pb + 2)) DUPLOOP(4) { P_BEGIN
            scan_phase<true>(WSP(bf16, WS_UX), WSP(bf16, WS_UG), WSP(bf16, WS_MIX), WSP(bf16, WS_GWT), WSP(float, WS_SUMM), inp[I_CONVW] + l * 4 * 512, inp[I_CONVB] + l * 512, inp[I_BA] + l * 1024,
                             inp[I_BI] + l * 1024, inp[I_LAM] + l * 1024, l, bx, last, ConvCtx{inp[I_WG], inp[I_WU], inp[I_WD], WSP(bf16, WS_BT1), WSP(bf16, WS_BT2), l, 1, 0, cv_nA(l) + CV_FOUR + (l == 0 ? NTAIL_L0 : NTAIL_L1)}, lds, tid);
        }
        SEAM(pb + 2);
        if (IN(pb + 3)) DUPLOOP(5) { P_BEGIN
            const int Mo = last ? MX : MALL;
            const int NGo = last ? G : NG_OUT0;
            pg8::Gemm g{WSP(bf16, WS_MIX), WSP(bf16, WS_WOUT) + (size_t)l * 1024 * 1024, Mo, D, D, D, nullptr}; pg8::StaticOrder S; S.init(Mo, D, NGo, bx);
            EpiOut E{WSP(xres_t, WS_XRES), WSP(float, WS_MOD) + l * 5 * 6144, (DUP_SITE == 5 && rep_ == 0) ? 0.f : 1.f};
            if (bx < NGo) pg8::gemm_phase<EpiOut, pg8::StaticOrder, true, true>(lds, g, S, E);
            if (!last && bx >= NG_OUT0) {
                const ConvCtx cc{inp[I_WG], inp[I_WU], inp[I_WD], WSP(bf16, WS_BT1), WSP(bf16, WS_BT2), 0, 0, 0, 0};
                conv_tail(cc, cv_nA(0) + CV_FOUR + NT_PROJ0, bx - NG_OUT0, 256 - NG_OUT0, TQ_OUT0, lane, wv);
            }
        }
        SEAM(pb + 3);
        if (IN(pb + 4)) DUPLOOP(6) { P_BEGIN
            const float* modl = WSP(float, WS_MOD) + l * 5 * 6144; xres_t* XRES = WSP(xres_t, WS_XRES); bf16* HN = WSP(bf16, WS_HN); float* AFF = WSP(float, WS_AFF);
            const float* wr = inp[I_WR] + (size_t)l * 1024 * 16;
            for (int i = tid; i < 4096; i += 512) *(f32x4*)(lds_raw + wr_addr(i >> 2) + (i & 3) * 16) = *(const f32x4*)(wr + (size_t)i * 4);
            __syncthreads();
            const int w = vcu, b = w >> 6;
            f32x4 A[4], Bv[4];
            load_modAB(inp[I_N2G] + l * 1024, modl, b, 3072, 4096, lane, A, Bv);
#pragma unroll 1
            for (int i = 0; i < 8; i += 2) { const int row = 64 * w + 8 * wv + i;
                norm2_router_rows<2>(XRES + (size_t)row * 1024, HN + (size_t)row * HNRS, AFF + (size_t)row * 16, A, Bv, lds_raw, lane); }
            if (!last && wv < 4) {
                load_modAB(inp[I_N2G] + l * 1024, modl, 4, 3072, 4096, lane, A, Bv);
                const int row = MX + 4 * w + wv;
                norm2_router_rows<1>(XRES + (size_t)row * 1024, HN + (size_t)row * HNRS, AFF + (size_t)row * 16, A, Bv, lds_raw, lane);
            }
            __syncthreads();
        }
        SEAM(pb + 4);
        if (IN(pb + 5)) DUPLOOP(7) { P_BEGIN
            const int nu = last ? 64 : 128;
            for (int u = bx; u < nu; u += G) topk_unit(u, WSP(float, WS_AFF), WSP(int, WS_SELTOK), WSP(float, WS_SELG), WSP(int, WS_TOKSLOT), lds_raw, tid);
        }
        SEAM(pb + 5);
        if (IN(pb + 7)) DUPLOOP(9) { P_BEGIN
            pg8::Gemm g{WSP(bf16, WS_HN), WSP(bf16, WS_BT1) + (size_t)l * 16 * 5632 * 1024, SLOTALL, 16 * 5632, D, D, WSP(int, WS_SELTOK)};   GroupedGatherOrder S; S.init(22, last ? 8 : 9, G, bx, 16, 0, G1_SEQ, G1_MG);
            EpiG1 E{WSP(bf16, WS_HID), 22};
            pg8::gemm_phase<EpiG1, GroupedGatherOrder, true, true>(lds, g, S, E);
            if (!last && bx >= 96) {
                const ConvCtx cc{inp[I_WG], inp[I_WU], inp[I_WD], WSP(bf16, WS_BT1), WSP(bf16, WS_BT2), 1, 0, 0, 0};
                conv_tail(cc, cv_nA(1) + CV_FOUR, bx - 96, 160, TQ_G1, lane, wv);
            }
        }
        SEAM(pb + 7);
        if (IN(pb + 8)) DUPLOOP(10) { P_BEGIN
            EpiG2 E{WSP(bf16, WS_YS), WSP(bf16, WS_YS2), WSP(float, WS_SELG)};
            { pg8::Gemm g{WSP(bf16, WS_HID), WSP(bf16, WS_BT2) + (size_t)l * 16 * 1024 * DFF, SLOTALL, 16 * 1024, DFF, DFF, nullptr}; GroupedOrder S; S.init(4, 8, G, bx, 44, 1);
              pg8::gemm_phase<EpiG2, GroupedOrder, true, true>(lds, g, S, E); }
            if (!last) { pg8::Gemm g{WSP(bf16, WS_HID), WSP(bf16, WS_BT2) + (size_t)l * 16 * 1024 * DFF, SLOTALL, 16 * 1024, DFF / 2, DFF, nullptr}; CtxSplitOrder S; S.init(G, bx, DFF / 2);
              pg8::gemm_phase<EpiG2, CtxSplitOrder, true, true>(lds, g, S, E);
              if (bx >= 128) {
                const ConvCtx cc{inp[I_WG], inp[I_WU], inp[I_WD], WSP(bf16, WS_BT1), WSP(bf16, WS_BT2), 1, 0, 0, 0};
                conv_tail(cc, cv_nA(1) + CV_FOUR + NT_G1, bx - 128, 128, TQ_G2, lane, wv);
              } }
        }
        SEAM(pb + 8);
        if (IN(pb + 9)) DUPLOOP(11) { P_BEGIN
            const float* MOD = WSP(float, WS_MOD); const float* modl = MOD + l * 5 * 6144; xres_t* XRES = WSP(xres_t, WS_XRES); bf16* HN = WSP(bf16, WS_HN);
            const int* TOKSLOT = WSP(int, WS_TOKSLOT); const bf16* YS = WSP(bf16, WS_YS);
            const int w = vcu, b = w >> 6;
            f32x4 G2[4], A[4], Bv[4];
#pragma unroll
            for (int j = 0; j < 4; ++j) G2[j] = *(const f32x4*)(modl + b * 6144 + 5120 + 4 * lane + 256 * j) * ((DUP_SITE == 11 && rep_ == 0) ? 0.f : 1.f);
            if (!last) load_modAB(inp[I_N1G] + (l + 1) * 1024, MOD + (l + 1) * 5 * 6144, b, 0, 1024, lane, A, Bv);
            else { const float* fg = inp[I_FG];
#pragma unroll
                for (int j = 0; j < 4; ++j) { A[j] = *(const f32x4*)(fg + 4 * lane + 256 * j); Bv[j] = (f32x4){0.f, 0.f, 0.f, 0.f}; }
            }
            float* outp = args.out;
            for (int i = 0; i < 8; ++i) {
                const int row = 64 * w + 8 * wv + i;
                f32x4 v[4];
                combine_row<false>(XRES + (size_t)row * 1024, TOKSLOT + (size_t)row * 16, YS, nullptr, G2, lane, v, !last);
                const float rstd = row_rstd(v);
#pragma unroll
                for (int j = 0; j < 4; ++j) v[j] = v[j] * rstd * A[j] + Bv[j];
                if (!last) row_store_bf16(HN + (size_t)row * 1024, v, lane);
                else {
#pragma unroll
                    for (int j = 0; j < 4; ++j) __builtin_nontemporal_store(v[j], (f32x4*)(outp + (size_t)row * 1024 + 4 * lane + 256 * j));
                }
            }
            if (!last && wv < 4) {
#pragma unroll
                for (int j = 0; j < 4; ++j) G2[j] = *(const f32x4*)(modl + 4 * 6144 + 5120 + 4 * lane + 256 * j) * ((DUP_SITE == 11 && rep_ == 0) ? 0.f : 1.f);
                load_modAB(inp[I_N1G] + (l + 1) * 1024, MOD + (l + 1) * 5 * 6144, 4, 0, 1024, lane, A, Bv);
                const int row = MX + 4 * w + wv;
                f32x4 v[4];
                combine_row<true>(XRES + (size_t)row * 1024, TOKSLOT + (size_t)row * 16, YS, WSP(bf16, WS_YS2), G2, lane, v);
                const float rstd = row_rstd(v);
#pragma unroll
                for (int j = 0; j < 4; ++j) v[j] = v[j] * rstd * A[j] + Bv[j];
                row_store_bf16(HN + (size_t)row * 1024, v, lane);
            }
        }
        if (!last) SEAM(pb + 9);
    }
#undef IN
#undef SEAM
}

extern "C" void kernel_launch(void* const* d_in, const int* in_sizes, int n_in, void* d_out, int out_size, void* d_ws, size_t ws_size, hipStream_t stream) {
    static int grid = 0;
    if (grid == 0) {
        if (n_in != 22 || out_size != MX * D || ws_size < WS_END) { fprintf(stderr, "kernel_launch: unexpected shapes (n_in %d out %d ws %zu)\n", n_in, out_size, ws_size); grid = -1; return; }
        int dev = 0, cus = 0, per_cu = 0;
        if (hipGetDevice(&dev) != hipSuccess || hipDeviceGetAttribute(&cus, hipDeviceAttributeMultiprocessorCount, dev) != hipSuccess) { grid = -1; return; }
        if (hipFuncSetAttribute((const void*)fwd_kernel, hipFuncAttributeMaxDynamicSharedMemorySize, LDS_BYTES) != hipSuccess) { fprintf(stderr, "kernel_launch: hipFuncSetAttribute failed\n"); grid = -1; return; }
        if (hipOccupancyMaxActiveBlocksPerMultiprocessor(&per_cu, (const void*)fwd_kernel, 512, LDS_BYTES) != hipSuccess || per_cu < 1) { fprintf(stderr, "kernel_launch: occupancy query reports %d\n", per_cu); }
        (void)hipGetLastError();
        grid = cus;
        if (grid != 256) { fprintf(stderr, "kernel_launch: this kernel is laid out for 256 CUs, found %d\n", cus); grid = -1; return; }
    }
    if (grid < 0) return;
    (void)hipMemsetAsync((char*)d_ws + WS_CTL, 0, CTL_ZERO_BYTES, stream);
    Args a{};
    for (int i = 0; i < 22; ++i) a.in[i] = (const float*)d_in[i];
    a.out = (float*)d_out; a.ws = (unsigned char*)d_ws;
#if MK_SPLIT
    for (int p = 0; p < NPH; ++p) { a.ph_lo = p; a.ph_hi = p + 1; hipLaunchKernelGGL(fwd_kernel, dim3(grid), dim3(512), LDS_BYTES, stream, a); }
#else
    a.ph_lo = 0; a.ph_hi = NPH;
    hipLaunchKernelGGL(fwd_kernel, dim3(grid), dim3(512), LDS_BYTES, stream, a);
#endif
}
```

```cpp
#include <hip/hip_runtime.h>
#include <cstdio>
#include <cstdint>
#define MK_SPLIT 0
#ifndef PG8_GATHER_KT_ROWS
#define PG8_GATHER_KT_ROWS 17408
#endif
#ifndef PG8_PREFETCH
#define PG8_PREFETCH 0
#endif
namespace pg8 {
#define PG8_LAS __attribute__((address_space(3)))
typedef unsigned short bf16_t;
typedef short bf16x8 __attribute__((ext_vector_type(8)));
typedef float f32x4 __attribute__((ext_vector_type(4)));
typedef unsigned u32x4 __attribute__((ext_vector_type(4)));
constexpr int BM = 256, BK = 64, HALF = 128, HTB = HALF * BK * 2  , STAGE_BYTES = 8 * HTB, NXCD = 8, WGM = 4;

__host__ __device__ __forceinline__ int lds_byte(int r, int c) { const int st = (r >> 4) * 2 + (c >> 5), rr = r & 15, cc = c & 31, ob = rr * 64 + cc * 2; return st * 1024 + (ob ^ (((ob >> 9) & 1) << 5)); }
__host__ __device__ __forceinline__ void stage_rc(int b, int& R, int& C) { const int st = b / 1024, sb = b % 1024, swz = sb ^ (((sb >> 9) & 1) << 5); R = (st >> 1) * 16 + swz / 64; C = (st & 1) * 32 + (swz % 64) / 2; }
__host__ __device__ __forceinline__ int perm32(int rho) { const int n = rho >> 4, i = rho & 15; return 8 * (i >> 2) + 4 * n + (i & 3); }

struct Unit { int pm, pn, ko; };
struct Gemm { const bf16_t* A; const bf16_t* Bt; int M, N, K, ld; const int* rowidx; };

struct StaticOrder {
    static constexpr bool GATHER = false; static constexpr int AUX_B = 0, HALF_PM = 1 << 30; static constexpr bool PF = PG8_PREFETCH;
    int nM, nN, nwg, G, c;
    __host__ __device__ void init(int M, int N, int G_, int c_) { nM = M / BM; nN = N / BM; nwg = nM * nN; G = G_; c = c_; }
    __host__ __device__ bool next(int i, Unit& u) const {
        const long L = (long)i * G + c; if (L >= nwg) return false;
        int wgid = (int)L; { const int q = nwg / NXCD, r = nwg % NXCD, xcd = wgid % NXCD, off = wgid / NXCD; wgid = (xcd < r ? xcd * (q + 1) : r * (q + 1) + (xcd - r) * q) + off; }
        const int nig = WGM * nN, gid = wgid / nig, fm = gid * WGM, gsz = (nM - fm) < WGM ? (nM - fm) : WGM;
        u.pm = fm + ((wgid % nig) % gsz); u.pn = (wgid % nig) / gsz; u.ko = 0; return true;
    }
    __device__ __forceinline__ void a_ready(const Unit&) const {}
    __device__ __forceinline__ void done(const Unit&) const {}
    __device__ __forceinline__ void warm(const Unit&, const char*, size_t, PG8_LAS unsigned char*, int) const {}
};
__device__ __forceinline__ unsigned cvt_pk_bf16(float lo, float hi) { unsigned r; asm volatile("v_cvt_pk_bf16_f32 %0, %1, %2" : "=v"(r) : "v"(lo), "v"(hi)); return r; }
typedef float f32x2 __attribute__((ext_vector_type(2)));
template <class Epi, class Sched, bool ALIGN_EPI = false, bool SP2 = false>
__device__ __forceinline__ void gemm_phase(PG8_LAS unsigned char* lds, const Gemm g, const Sched& S, const Epi& E) {
    int tid = threadIdx.x; asm volatile("" : "+v"(tid));
    const int wid = __builtin_amdgcn_readfirstlane(tid >> 6), lane = tid & 63, wr = wid >> 2, wc = wid & 3, fr = lane & 15, fq = lane >> 4;
    const int K = g.K, nt = K / BK, LD = g.ld;
    constexpr bool GATHER = Sched::GATHER;
    static_assert(!GATHER || SP2, "the gathered A path is written for the SP2 loop");
    unsigned voffA[2], voffB[2]; int Rl[2], Cl2[2];
#pragma unroll
    for (int i = 0; i < 2; ++i) { int R, C; stage_rc(tid * 16 + i * 8192, R, C); const int Rb = Epi::PERM ? ((R & ~31) + perm32(R & 31)) : R; Rl[i] = R; Cl2[i] = C * 2;
        voffA[i] = (unsigned)(R * LD + C) * 2u; voffB[i] = (unsigned)(Rb * LD + C) * 2u; }
    unsigned gAc[2][2], gAn[2][2], gA2[2][2]; int graw[2][2];
#define PG8_GISSUE(u) do { _Pragma("unroll") for (int _h = 0; _h < 2; ++_h) _Pragma("unroll") for (int _i = 0; _i < 2; ++_i) graw[_h][_i] = g.rowidx[(u).pm * 256 + _h * 128 + Rl[_i]]; } while (0)
#define PG8_GFIN(o) do { _Pragma("unroll") for (int _h = 0; _h < 2; ++_h) _Pragma("unroll") for (int _i = 0; _i < 2; ++_i) (o)[_h][_i] = (unsigned)(graw[_h][_i] < 0 ? 0 : graw[_h][_i]) * (unsigned)(PG8_GATHER_KT_ROWS ? 128 : LD * 2) + (unsigned)Cl2[_i]; } while (0)
#define PG8_GCOPY(d, s) do { _Pragma("unroll") for (int _h = 0; _h < 2; ++_h) _Pragma("unroll") for (int _i = 0; _i < 2; ++_i) (d)[_h][_i] = (s)[_h][_i]; } while (0)
    const size_t kstep = (size_t)(BK * 2);
    constexpr bool PF = Sched::PF && !GATHER;
    const unsigned voffP = (unsigned)(((wid & 3) * 64 + lane) * LD) * 2u;
#define PG8_PF(pa, pb) do { if constexpr (PF) __builtin_amdgcn_global_load_lds((const unsigned*)(((wid < 4) ? (pa) : (pb)) + voffP), (PG8_LAS unsigned*)(lds + STAGE_BYTES + 512), 4, 0, 0); } while (0)
#define PG8_WAIT_VP() do { if constexpr (PF) PG8_WAIT_V(9); else PG8_WAIT_V(8); } while (0)
    const size_t kstepA = (GATHER && PG8_GATHER_KT_ROWS) ? (size_t)PG8_GATHER_KT_ROWS * 128 : kstep;
    const size_t hstep = (size_t)HALF * LD * 2;
    const size_t tstep = 2 * hstep;
    const unsigned ldsw = (unsigned)wid * 1024u;
    const int aoff = lds_byte(wr * 64 + fr, fq * 8), boff = lds_byte(wc * 32 + fr, fq * 8);
#define PG8_SA(b, h) (((b) * 2 + (h)) * HTB)
#define PG8_SB(b, h) ((4 + (b) * 2 + (h)) * HTB)
#define PG8_STAGE(bufoff, gbase, voff) do { _Pragma("unroll") for (int _i = 0; _i < 2; ++_i) \
        __builtin_amdgcn_global_load_lds((const unsigned*)((const char*)(gbase) + (voff)[_i]), (PG8_LAS unsigned*)(lds + (bufoff) + ldsw + _i * 8192), 16, 0, ((bufoff) >= 4 * HTB) ? Sched::AUX_B : 0); } while (0)
#define PG8_LDA(dst, b, h) do { _Pragma("unroll") for (int m = 0; m < 4; ++m) _Pragma("unroll") for (int k = 0; k < 2; ++k) dst[m][k] = *(const PG8_LAS bf16x8*)(lds + PG8_SA(b, h) + aoff + m * 2048 + k * 1024); } while (0)
#define PG8_LDB(dst, b, h) do { _Pragma("unroll") for (int n = 0; n < 2; ++n) _Pragma("unroll") for (int k = 0; k < 2; ++k) dst[n][k] = *(const PG8_LAS bf16x8*)(lds + PG8_SB(b, h) + boff + n * 2048 + k * 1024); } while (0)
#define PG8_MMA(ai, bj, At, Bt) do { __builtin_amdgcn_s_setprio(1); _Pragma("unroll") for (int m = 0; m < 4; ++m) _Pragma("unroll") for (int n = 0; n < 2; ++n) _Pragma("unroll") for (int k = 0; k < 2; ++k) \
        acc[ai][bj][m][n] = __builtin_amdgcn_mfma_f32_16x16x32_bf16(Bt[n][k], At[m][k], acc[ai][bj][m][n], 0, 0, 0); __builtin_amdgcn_s_setprio(0); } while (0)
#define PG8_WAIT_V(n) asm volatile("s_waitcnt vmcnt(" #n ")" ::: "memory")
#define PG8_WAIT_L(n) asm volatile("s_waitcnt lgkmcnt(" #n ")" ::: "memory")
#define PG8_BAR __builtin_amdgcn_s_barrier()
#define PG8_SCHED __builtin_amdgcn_sched_barrier(0)
    Unit cur, nxt; int ui = 0;
    if (!S.next(0, cur)) return;
    f32x4 acc[2][2][4][2];
#pragma unroll
    for (int a = 0; a < 2; ++a)
#pragma unroll
        for (int b = 0; b < 2; ++b)
#pragma unroll
            for (int m = 0; m < 4; ++m)
#pragma unroll
                for (int n = 0; n < 2; ++n) acc[a][b][m][n] = (f32x4){0.f, 0.f, 0.f, 0.f};
    bf16x8 At[4][2], B0[2][2], B1[2][2];
    const char* cA = (const char*)g.A + (GATHER ? (size_t)0 : (size_t)cur.pm * tstep) + (size_t)cur.ko * 2; const char* cB = (const char*)g.Bt + (size_t)cur.pn * tstep + (size_t)cur.ko * 2;
    S.a_ready(cur);
    if constexpr (GATHER) { PG8_GISSUE(cur); PG8_GFIN(gAc); Unit n1; if (S.next(1, n1)) { PG8_GISSUE(n1); PG8_GFIN(gAn); } else PG8_GCOPY(gAn, gAc); PG8_GCOPY(gA2, gAn); }
#define PG8_STAGE_A(bufoff, kptr, h, offs) do { if constexpr (GATHER) PG8_STAGE(bufoff, kptr, (offs)[h]); else PG8_STAGE(bufoff, (kptr) + (h) * hstep, voffA); } while (0)
    if constexpr (SP2) {
        PG8_STAGE(PG8_SB(0, 0), cB, voffB); PG8_STAGE(PG8_SB(0, 1), cB + hstep, voffB); PG8_STAGE_A(PG8_SA(0, 0), cA, 0, gAc); PG8_STAGE_A(PG8_SA(0, 1), cA, 1, gAc);
        if (wr == 1) PG8_BAR;
        PG8_WAIT_V(2); PG8_BAR;
        PG8_STAGE(PG8_SB(1, 0), cB + kstep, voffB); PG8_STAGE_A(PG8_SA(1, 0), cA + kstepA, 0, gAc); PG8_STAGE(PG8_SB(1, 1), cB + hstep + kstep, voffB);
        PG8_WAIT_V(6); PG8_BAR;
    } else {
        PG8_STAGE(PG8_SB(0, 0), cB, voffB); PG8_STAGE(PG8_SA(0, 0), cA, voffA); PG8_STAGE(PG8_SB(0, 1), cB + hstep, voffB); PG8_STAGE(PG8_SA(0, 1), cA + hstep, voffA);
        if (wr == 1) PG8_BAR;
        PG8_WAIT_V(4); PG8_BAR;
        PG8_STAGE(PG8_SB(1, 0), cB + kstep, voffB); PG8_STAGE(PG8_SA(1, 0), cA + kstep, voffA); PG8_STAGE(PG8_SB(1, 1), cB + hstep + kstep, voffB);
        PG8_WAIT_V(6); PG8_BAR;
    }
    for (;;) {
        const bool has_next = S.next(ui + 1, nxt);
        const bool hm = cur.pm >= Sched::HALF_PM;
        const char* nA = has_next ? (const char*)g.A + (GATHER ? (size_t)0 : (size_t)nxt.pm * tstep) + (size_t)nxt.ko * 2 : cA; const char* nB = has_next ? (const char*)g.Bt + (size_t)nxt.pn * tstep + (size_t)nxt.ko * 2 : cB;
        for (int t = 0; t < nt; t += 2) {
            const bool last = (t == nt - 2);
            const char* a1 = cA + (size_t)(t + 1) * kstepA;
            const char* a2 = last ? nA : cA + (size_t)(t + 2) * kstepA; const char* b2 = last ? nB : cB + (size_t)(t + 2) * kstep;
            const char* a3 = a2 + kstepA; const char* b3 = b2 + kstep;
            const char* pa3 = (t + 3 < nt) ? cA + (size_t)(t + 3) * kstepA : nA + (size_t)(t + 3 - nt) * kstepA; const char* pb3 = (t + 3 < nt) ? cB + (size_t)(t + 3) * kstep : nB + (size_t)(t + 3 - nt) * kstep;
            const char* pa4 = (t + 4 < nt) ? cA + (size_t)(t + 4) * kstepA : nA + (size_t)(t + 4 - nt) * kstepA; const char* pb4 = (t + 4 < nt) ? cB + (size_t)(t + 4) * kstep : nB + (size_t)(t + 4 - nt) * kstep;
            if (last && has_next) S.a_ready(nxt);
            unsigned o2[2][2];
            if constexpr (GATHER) { _Pragma("unroll") for (int _h = 0; _h < 2; ++_h) _Pragma("unroll") for (int _i = 0; _i < 2; ++_i) o2[_h][_i] = last ? gAn[_h][_i] : gAc[_h][_i]; }
            if constexpr (SP2) {
            PG8_LDB(B0, 0, 0); PG8_LDB(B1, 0, 1); PG8_SCHED; PG8_LDA(At, 0, 0); PG8_STAGE_A(PG8_SA(1, 1), a1, 1, gAc);
            PG8_WAIT_VP(); PG8_WAIT_L(0); PG8_BAR; PG8_MMA(0, 0, At, B0); PG8_MMA(0, 1, At, B1); PG8_BAR; PG8_SCHED;
            PG8_LDA(At, 0, 1); PG8_STAGE(PG8_SB(0, 0), b2, voffB); PG8_STAGE(PG8_SB(0, 1), b2 + hstep, voffB); PG8_STAGE_A(PG8_SA(0, 0), a2, 0, o2); PG8_PF(pa3, pb3);
            PG8_WAIT_VP(); PG8_WAIT_L(0); PG8_BAR; if (!hm) { PG8_MMA(1, 0, At, B0); PG8_MMA(1, 1, At, B1); } PG8_BAR; PG8_SCHED;
            PG8_LDB(B0, 1, 0); PG8_LDB(B1, 1, 1); PG8_SCHED; PG8_LDA(At, 1, 0); PG8_STAGE_A(PG8_SA(0, 1), a2, 1, o2);
            PG8_WAIT_VP(); PG8_WAIT_L(0); PG8_BAR; PG8_MMA(0, 0, At, B0); PG8_MMA(0, 1, At, B1); PG8_BAR; PG8_SCHED;
            PG8_LDA(At, 1, 1); PG8_STAGE(PG8_SB(1, 0), b3, voffB); PG8_STAGE(PG8_SB(1, 1), b3 + hstep, voffB); PG8_STAGE_A(PG8_SA(1, 0), a3, 0, o2); PG8_PF(pa4, pb4);
            PG8_WAIT_VP(); PG8_WAIT_L(0); PG8_BAR; if (!hm) { PG8_MMA(1, 0, At, B0); PG8_MMA(1, 1, At, B1); } PG8_BAR; PG8_SCHED;
            } else {
            PG8_LDB(B0, 0, 0); PG8_SCHED; PG8_LDA(At, 0, 0); PG8_STAGE(PG8_SA(1, 1), a1 + hstep, voffA);
            PG8_WAIT_L(8); PG8_BAR; PG8_WAIT_L(0); PG8_MMA(0, 0, At, B0); PG8_BAR; PG8_SCHED;
            PG8_LDB(B1, 0, 1); PG8_STAGE(PG8_SB(0, 0), b2, voffB);
            PG8_BAR; PG8_WAIT_L(0); PG8_MMA(0, 1, At, B1); PG8_BAR;
            PG8_LDA(At, 0, 1); PG8_STAGE(PG8_SA(0, 0), a2, voffA);
            PG8_BAR; PG8_WAIT_L(0); PG8_MMA(1, 0, At, B0); PG8_BAR; PG8_SCHED;
            PG8_STAGE(PG8_SB(0, 1), b2 + hstep, voffB);
            PG8_WAIT_V(6); PG8_BAR; PG8_MMA(1, 1, At, B1); PG8_BAR;
            PG8_LDB(B0, 1, 0); PG8_SCHED; PG8_LDA(At, 1, 0); PG8_STAGE(PG8_SA(0, 1), a2 + hstep, voffA);
            PG8_WAIT_L(8); PG8_BAR; PG8_WAIT_L(0); PG8_MMA(0, 0, At, B0); PG8_BAR; PG8_SCHED;
            PG8_LDB(B1, 1, 1); PG8_STAGE(PG8_SB(1, 0), b3, voffB);
            PG8_BAR; PG8_WAIT_L(0); PG8_MMA(0, 1, At, B1); PG8_BAR;
            PG8_LDA(At, 1, 1); PG8_STAGE(PG8_SA(1, 0), a3, voffA);
            PG8_BAR; PG8_WAIT_L(0); PG8_MMA(1, 0, At, B0); PG8_BAR; PG8_SCHED;
            PG8_STAGE(PG8_SB(1, 1), b3 + hstep, voffB);
            PG8_WAIT_V(6); PG8_BAR; PG8_MMA(1, 1, At, B1); PG8_BAR;
            }
        }
        if constexpr (ALIGN_EPI) { if (wr == 0) PG8_BAR; }
        if (has_next) S.warm(nxt, nB, hstep, lds + STAGE_BYTES + 512, tid);
        bool has2 = false; if constexpr (GATHER) { Unit nx2; has2 = has_next && S.next(ui + 2, nx2); if (has2) PG8_GISSUE(nx2); }
        if constexpr (!Epi::AFTER_DRAIN) { E(acc, cur, wr, wc, fr, fq); S.done(cur); }
        if constexpr (GATHER) { if (has2) PG8_GFIN(gA2); else PG8_GCOPY(gA2, gAn); }
        if (!has_next) break;
#pragma unroll
        for (int a = 0; a < 2; ++a)
#pragma unroll
            for (int b = 0; b < 2; ++b)
#pragma unroll
                for (int m = 0; m < 4; ++m)
#pragma unroll
                    for (int n = 0; n < 2; ++n) acc[a][b][m][n] = (f32x4){0.f, 0.f, 0.f, 0.f};
        cur = nxt; cA = nA; cB = nB; ++ui;
        if constexpr (GATHER) { PG8_GCOPY(gAc, gAn); PG8_GCOPY(gAn, gA2); }
        if constexpr (ALIGN_EPI) { if (wr == 1) PG8_BAR; }
    }
    PG8_WAIT_V(0);
    if constexpr (!ALIGN_EPI) { if (wr == 0) PG8_BAR; }
    PG8_BAR;
    if constexpr (Epi::AFTER_DRAIN) { E.fused(acc, cur, wr, wc, fr, fq, lds, wid, lane); S.done(cur); }
#undef PG8_SA
#undef PG8_PF
#undef PG8_WAIT_VP
#undef PG8_STAGE_A
#undef PG8_GISSUE
#undef PG8_GFIN
#undef PG8_GCOPY
#undef PG8_SB
#undef PG8_STAGE
#undef PG8_LDA
#undef PG8_LDB
#undef PG8_MMA
#undef PG8_WAIT_V
#undef PG8_WAIT_L
#undef PG8_BAR
#undef PG8_SCHED
}
}

#ifndef XBF16
#define XBF16 1
#endif
#ifndef MK_SPLIT
#define MK_SPLIT 0
#endif
constexpr int D = 1024, NB = 4, SEQ = 4096, CTXL = 256, DEPTH = 2;
constexpr int MX = NB * SEQ;
constexpr int MC = NB * CTXL;
constexpr int MALL = MX + MC;
constexpr int NPROJ = 2048;
constexpr int DFF = 2816, NE = 16, CAPX = 512, CAPC = 32;
constexpr int SLOTX = NE * NB * CAPX;
constexpr int SLOTALL = SLOTX + NE * 256;
constexpr int NCHUNK = 68;
constexpr int NPH = 22;

constexpr size_t MiB = 1u << 20;
constexpr size_t WS_CTL = 0, CTL_ZERO_BYTES = 64 * 1024;
constexpr size_t WS_MOD = 1 * MiB;
constexpr size_t WS_PE = WS_MOD + 256 * 1024;
constexpr size_t WS_M1 = WS_PE + 128 * 1024;
constexpr size_t WS_M3 = WS_M1 + 32768;
constexpr size_t WS_GWT = 2 * MiB;
constexpr size_t WS_MCT = 2 * MiB + 512 * 1024;
constexpr size_t WS_SUMM = 3 * MiB;
constexpr size_t WS_AFF = 6 * MiB;
constexpr size_t WS_TOKSLOT = 8 * MiB;
constexpr size_t WS_SELTOK = 10 * MiB;
constexpr size_t WS_SELG = 10 * MiB + 256 * 1024;
constexpr size_t WS_WIN = 12 * MiB;
constexpr size_t WS_WOUT = 20 * MiB;
constexpr size_t WS_BT1 = 24 * MiB;
constexpr size_t WS_BT2 = 376 * MiB;
constexpr size_t WS_XRES = 552 * MiB;
constexpr size_t WS_HN = 620 * MiB;
constexpr size_t WS_VX = 654 * MiB;
constexpr size_t WS_VC = 686 * MiB;
constexpr size_t WS_UX = 688 * MiB;
constexpr size_t WS_UG = 705 * MiB;
constexpr size_t WS_MIX = 722 * MiB;
constexpr size_t WS_XG = 756 * MiB;
constexpr size_t WS_HID = 828 * MiB;
constexpr size_t WS_YS = 1026 * MiB;
constexpr size_t WS_YS2 = 1098 * MiB;
constexpr size_t WS_END = 1106 * MiB;
constexpr int CW_BAR = 1024;

constexpr int RING_BYTES = 131072;
constexpr int MISC_OFF = RING_BYTES;
constexpr int LDS_BYTES = RING_BYTES + 1024;

#define LAS __attribute__((address_space(3)))
typedef unsigned short bf16;
typedef float f32x4 __attribute__((ext_vector_type(4)));
typedef float f32x2 __attribute__((ext_vector_type(2)));
typedef float f32x16 __attribute__((ext_vector_type(16)));
typedef short bf16x8 __attribute__((ext_vector_type(8)));
typedef unsigned u32x4 __attribute__((ext_vector_type(4)));
typedef unsigned u32x2 __attribute__((ext_vector_type(2)));

__device__ __forceinline__ unsigned pk2(float lo, float hi) { return pg8::cvt_pk_bf16(lo, hi); }
__device__ __forceinline__ float bflo(unsigned u) { return __builtin_bit_cast(float, u << 16); }
__device__ __forceinline__ float bfhi(unsigned u) { return __builtin_bit_cast(float, u & 0xffff0000u); }
__device__ __forceinline__ unsigned short f2bf1(float f) { return (unsigned short)(pk2(f, 0.f) & 0xffffu); }
#ifndef SCAN_DPP
#define SCAN_DPP 1
#endif
#ifndef XLANE_VALU
#define XLANE_VALU 1
#endif
__device__ __forceinline__ float xl_xor1(float v) { return __builtin_bit_cast(float, __builtin_amdgcn_update_dpp(0, __builtin_bit_cast(int, v), 0xB1, 0xF, 0xF, true)); }
__device__ __forceinline__ float xl_xor2(float v) { return __builtin_bit_cast(float, __builtin_amdgcn_update_dpp(0, __builtin_bit_cast(int, v), 0x4E, 0xF, 0xF, true)); }
__device__ __forceinline__ float xl_hmir(float v) { return __builtin_bit_cast(float, __builtin_amdgcn_update_dpp(0, __builtin_bit_cast(int, v), 0x141, 0xF, 0xF, true)); }
__device__ __forceinline__ float xl_mir(float v)  { return __builtin_bit_cast(float, __builtin_amdgcn_update_dpp(0, __builtin_bit_cast(int, v), 0x140, 0xF, 0xF, true)); }
__device__ __forceinline__ float xl_xor16(float v, int lane) {
    const unsigned u = __builtin_bit_cast(unsigned, v); const auto r = __builtin_amdgcn_permlane16_swap(u, u, false, false);
    return __builtin_bit_cast(float, (lane & 16) ? (unsigned)r[0] : (unsigned)r[1]); }
__device__ __forceinline__ float xl_xor32(float v, int lane) {
    const unsigned u = __builtin_bit_cast(unsigned, v); const auto r = __builtin_amdgcn_permlane32_swap(u, u, false, false);
    return __builtin_bit_cast(float, (lane & 32) ? (unsigned)r[0] : (unsigned)r[1]); }
__device__ __forceinline__ float row16_sum(float v) { v += xl_xor1(v); v += xl_xor2(v); v += xl_hmir(v); v += xl_mir(v); return v; }
__device__ __forceinline__ float row16_max(float v) { v = fmaxf(v, xl_xor1(v)); v = fmaxf(v, xl_xor2(v)); v = fmaxf(v, xl_hmir(v)); v = fmaxf(v, xl_mir(v)); return v; }
__device__ __forceinline__ float wave_sum(float v) {
#if XLANE_VALU
    const int lane = threadIdx.x & 63;
    v = row16_sum(v); v += xl_xor16(v, lane); v += xl_xor32(v, lane);
    return v;
#else
#pragma unroll
    for (int o = 1; o < 64; o <<= 1) v += __shfl_xor(v, o);
    return v;
#endif
}

#define XB_TMO      128
#define XB_XCNT(j)  (256  + 64 * (j))
#define XB_XSUB(j)  (1280 + 64 * (j))
#define XB_XGEN(j)  (2304 + 64 * (j))
#define XB_TOP      3328
#define XB_TOPGEN   3392
#define XCD_BAR_WORDS 3456
#define XB_SPIN_CAP (1u << 18)
__device__ __forceinline__ unsigned xb_ld(unsigned* p)              { return __hip_atomic_load(p, __ATOMIC_RELAXED, __HIP_MEMORY_SCOPE_AGENT); }
__device__ __forceinline__ unsigned xb_add(unsigned* p, unsigned v) { return __hip_atomic_fetch_add(p, v, __ATOMIC_RELAXED, __HIP_MEMORY_SCOPE_AGENT); }
__device__ __forceinline__ unsigned xb_xcc_id() { return (unsigned)__builtin_amdgcn_s_getreg((3 << 11) | 20) & 0xFu; }
#define XB_SPIN(cond, bar) do { unsigned _sp = 0; while (cond) { __builtin_amdgcn_s_sleep(1); \
    if ((++_sp & 255u) == 0u) { if (xb_ld(&(bar)[XB_TMO])) break; if (_sp > XB_SPIN_CAP) { atomicAdd(&(bar)[XB_TMO], 1u); break; } } } } while (0)
struct XcdBarrier { unsigned* bar; unsigned x; volatile LAS unsigned* st; };
__device__ __forceinline__ XcdBarrier xcd_barrier_post(unsigned* bar, volatile LAS unsigned* st) {
    XcdBarrier b; b.bar = bar; b.x = xb_xcc_id(); b.st = st;
    if (threadIdx.x == 0) (void)xb_add(&bar[XB_XCNT(b.x)], 1u);
    return b;
}
__device__ __forceinline__ void xcd_barrier_complete(unsigned* bar, unsigned x, unsigned& nloc, unsigned& nx) {
    const unsigned G = gridDim.x * gridDim.y * gridDim.z;
    unsigned sum, cnt, mine, sp = 0u;
    for (;;) {
        sum = 0u; cnt = 0u; mine = 0u;
#pragma unroll
        for (unsigned j = 0; j < 16; ++j) { const unsigned c = xb_ld(&bar[XB_XCNT(j)]); sum += c; cnt += (c > 0u) ? 1u : 0u; mine = (j == x) ? c : mine; }
        if (sum == G) break;
        __builtin_amdgcn_s_sleep(1);
        if ((++sp & 255u) == 0u) { if (xb_ld(&bar[XB_TMO])) break; if (sp > XB_SPIN_CAP) { atomicAdd(&bar[XB_TMO], 1u); break; } }
    }
    nloc = mine > 0u ? mine : 1u; nx = cnt > 0u ? cnt : 1u;
}
__device__ __forceinline__ void xcd_barrier(const XcdBarrier& b) {
    asm volatile("s_waitcnt vmcnt(0)" ::: "memory");
    __syncthreads();
    if (threadIdx.x == 0) {
        unsigned* bar = b.bar;
        __builtin_amdgcn_s_waitcnt(0);
        unsigned nloc = b.st[0], nx = b.st[1];
        if (nloc == 0u) { xcd_barrier_complete(bar, b.x, nloc, nx); b.st[0] = nloc; b.st[1] = nx; }
        const unsigned old = xb_add(&bar[XB_XSUB(b.x)], 1u);
        const unsigned gen = old / nloc;
        if (old + 1u == (gen + 1u) * nloc) {
            __builtin_amdgcn_fence(__ATOMIC_RELEASE, "agent");
            asm volatile("s_waitcnt vmcnt(0)" ::: "memory");
            const unsigned og = xb_add(&bar[XB_TOP], 1u);
            const unsigned tg = og / nx;
            if (og + 1u == (tg + 1u) * nx) xb_add(&bar[XB_TOPGEN], 1u);
            else XB_SPIN(xb_ld(&bar[XB_TOPGEN]) == tg, bar);
            __builtin_amdgcn_fence(__ATOMIC_ACQUIRE, "agent");
            xb_add(&bar[XB_XGEN(b.x)], 1u);
            asm volatile("s_waitcnt vmcnt(0)" ::: "memory");
        } else {
            XB_SPIN(xb_ld(&bar[XB_XGEN(b.x)]) == gen, bar);
            __builtin_amdgcn_fence(__ATOMIC_ACQUIRE, "agent");
            asm volatile("s_waitcnt vmcnt(0)" ::: "memory");
        }
    }
    __syncthreads();
}

__device__ __forceinline__ void tr_load(const float* W, int ldn, int kbase, int nbase, int lane, f32x4 (&v)[8]) {
    const int k0 = (lane >> 3) * 8, n0 = (lane & 7) * 4;
    const float* src = W + (size_t)(kbase + k0) * ldn + nbase + n0;
#pragma unroll
    for (int i = 0; i < 8; ++i) v[i] = __builtin_nontemporal_load((const f32x4*)(src + (size_t)i * ldn));
}
__device__ __forceinline__ void tr_store(const f32x4 (&v)[8], bf16* WT, int K, int kbase, int drow0, int lane) {
    const int k0 = (lane >> 3) * 8, n0 = (lane & 7) * 4;
#pragma unroll
    for (int j = 0; j < 4; ++j) {
        u32x4 o; o.x = pk2(v[0][j], v[1][j]); o.y = pk2(v[2][j], v[3][j]); o.z = pk2(v[4][j], v[5][j]); o.w = pk2(v[6][j], v[7][j]);
        __builtin_nontemporal_store(o, (u32x4*)(WT + (size_t)(drow0 + n0 + j) * K + kbase + k0));
    }
}
__device__ __forceinline__ void tr_item(const float* W, int K, int ldn, int kbase, int nbase, bf16* WT, int drow0, int lane) {
    f32x4 v[8]; tr_load(W, ldn, kbase, nbase, lane, v); tr_store(v, WT, K, kbase, drow0, lane);
}
struct DownItem { const float* src; bf16* dst; int kbase, nbase; };
__device__ __forceinline__ DownItem down_item(const float* w_down, bf16* BT2, int it) {
    const int le = it / 1408, r = it % 1408; DownItem d; d.src = w_down + (size_t)le * DFF * 1024; d.dst = BT2 + (size_t)le * 1024 * DFF; d.kbase = (r >> 5) * 64; d.nbase = (r & 31) * 32; return d;
}
struct GuItem { size_t soff; bf16* dst; int kbase, nbase, drow0; };
__device__ __forceinline__ GuItem gu_item(bf16* BT1, int it) {
    const int le = it / 1408, r = it % 1408, kb = r / 88, nb = r % 88; GuItem g; g.soff = (size_t)le * 1024 * DFF; g.dst = BT1 + (size_t)le * 5632 * 1024; g.kbase = kb * 64; g.nbase = nb * 32;
    g.drow0 = (g.nbase >> 7) * 256 + (g.nbase & 127); return g;
}
struct ConvCtx { const float *wg, *wu, *wd; bf16 *BT1, *BT2; int layer, pass, nA, bgu0; };
struct CItem { const float* src; bf16* dst; int ldn, Kd, kbase, nbase, drow0; };
__device__ __forceinline__ CItem citem_gu(const ConvCtx& c, int sgl) {
    const int up = sgl >= 16 * 1408, it = up ? sgl - 16 * 1408 : sgl;
    const GuItem g = gu_item(c.BT1, c.layer * 16 * 1408 + it);
    CItem r; r.src = (up ? c.wu : c.wg) + g.soff; r.dst = g.dst; r.ldn = DFF; r.Kd = 1024; r.kbase = g.kbase; r.nbase = g.nbase; r.drow0 = g.drow0 + (up ? 128 : 0); return r;
}
__device__ __forceinline__ CItem citem_down(const ConvCtx& c, int it) {
    const DownItem d = down_item(c.wd, c.BT2, c.layer * 16 * 1408 + it);
    CItem r; r.src = d.src; r.dst = d.dst; r.ldn = 1024; r.Kd = DFF; r.kbase = d.kbase; r.nbase = d.nbase; r.drow0 = d.nbase; return r;
}
constexpr int CV_SLOTS = 256 * 9 * 8;
constexpr int TQ_PROJ = 5, TQ_OUT = 6, TQ_G1 = 5, TQ_G2 = 8;
constexpr int NT_PROJ = 224 * 8 * TQ_PROJ, NT_OUT = 240 * 8 * TQ_OUT, NT_G1 = 160 * 8 * TQ_G1, NT_G2 = 128 * 8 * TQ_G2;
#ifndef NG_PROJ0
#define NG_PROJ0 184
#endif
#ifndef NG_OUT0
#define NG_OUT0 136
#endif
#ifndef TQ_PROJ0
#define TQ_PROJ0 20
#endif
#ifndef TQ_OUT0
#define TQ_OUT0 10
#endif
constexpr int NT_PROJ0 = (256 - NG_PROJ0) * 8 * TQ_PROJ0, NT_OUT0 = (256 - NG_OUT0) * 8 * TQ_OUT0;
#ifndef TQ_PROJ1
#define TQ_PROJ1 16
#endif
constexpr int NT_PROJ1 = (256 - NG_PROJ0) * 8 * TQ_PROJ1;
constexpr int NTAIL_L0 = NT_PROJ0 + NT_OUT0, NTAIL_L1 = NT_G1 + NT_G2 + NT_PROJ1;
__device__ __forceinline__ bool conv_pick(const ConvCtx& c, int slot, int which, CItem& it) {
    if (c.pass == 0) { if (which != 0 || slot >= c.nA) return false; it = citem_gu(c, slot); return true; }
    if (which == 0) { it = citem_down(c, slot); return true; }
    if (slot % 3 >= 2) return false;
    const int j = (slot / 3) * 2 + slot % 3;
    if (j < 4096) { it = citem_down(c, CV_SLOTS + j); return true; }
    if (c.bgu0 + j - 4096 >= 32 * 1408) return false;
    it = citem_gu(c, c.bgu0 + j - 4096);
    return true;
}
constexpr int CV_FOUR = 8192;
__device__ __forceinline__ int cv_nA(int l) { return l == 0 ? 45056 - CV_FOUR - NTAIL_L0 : 45056 - CV_FOUR - NTAIL_L1; }

__device__ __forceinline__ void conv_tail(const ConvCtx& c, int first, int r, int nidle, int Q, int lane, int wv) {
    f32x4 va[8], vb[8]; CItem ia, ib;
    ia = citem_gu(c, first + r * 8 + wv); tr_load(ia.src, ia.ldn, ia.kbase, ia.nbase, lane, va);
    for (int q = 0; q < Q; q += 2) {
        const bool hb = q + 1 < Q;
        if (hb) { ib = citem_gu(c, first + ((q + 1) * nidle + r) * 8 + wv); tr_load(ib.src, ib.ldn, ib.kbase, ib.nbase, lane, vb); }
        tr_store(va, ia.dst, ia.Kd, ia.kbase, ia.drow0, lane);
        if (q + 2 < Q) { ia = citem_gu(c, first + ((q + 2) * nidle + r) * 8 + wv); tr_load(ia.src, ia.ldn, ia.kbase, ia.nbase, lane, va); }
        if (hb) tr_store(vb, ib.dst, ib.Kd, ib.kbase, ib.drow0, lane);
    }
}

#ifndef G1_AUX_B
#define G1_AUX_B 0
#endif
#ifndef EXPERT_AUX_B
#define EXPERT_AUX_B 0
#endif
#ifndef G2_MG
#define G2_MG 2
#endif
#ifndef G1_MG
#define G1_MG 2
#endif
#ifndef G1_SEQ
#define G1_SEQ 0
#endif
#ifndef WARM_B
#define WARM_B 0
#endif
#ifndef HALF_CTX
#define HALF_CTX 1
#endif
template <bool GATHER_> struct GroupedOrderT {
    static constexpr bool GATHER = GATHER_; static constexpr int AUX_B = GATHER_ ? G1_AUX_B : EXPERT_AUX_B, HALF_PM = HALF_CTX ? 128 : (1 << 30); static constexpr bool PF = PG8_PREFETCH;
    int TN, MT, nwg, G, c, nlines, erev, seq, mg;
    __device__ void init(int TN_, int MT_, int G_, int c_, int nlines_, int erev_ = 0, int seq_ = 0, int mg_ = 0) { TN = TN_; MT = MT_; nwg = NE * TN * MT; G = G_; c = c_; nlines = nlines_; erev = erev_; seq = seq_; mg = mg_; }
    __device__ bool next(int i, pg8::Unit& u) const {
        const long L = (long)i * G + c; if (L >= nwg) return false;
        const int q = nwg / 8, xcd = (int)(L % 8);
        int off = (int)(L / 8);
        if (seq) {
            const int r = c / 8, nr = G / 8, base = q / nr, rem = q % nr;
            if (i >= base + (r < rem ? 1 : 0)) return false;
            off = r * base + (r < rem ? r : rem) + i;
        }
        int mt, j, e;
        if (mg) {
            const int PE = TN * MT, el = off / PE, o = off % PE, nb = TN * mg, ngrp = 8 / mg;
            if (o < nb * ngrp) { const int h = o / nb, r = o % nb; j = r / mg; mt = h * mg + r % mg; }
            else { j = o - nb * ngrp; mt = 8; }
            e = (xcd * 2 + el) ^ erev;
        } else { const int W = xcd * q + off; mt = W % MT; const int rest = W / MT; j = rest % TN; e = (rest / TN) ^ erev; }
        u.pm = (mt < 8) ? e * 8 + mt : 128 + e; u.pn = e * TN + j; u.ko = 0; return true;
    }
    __device__ __forceinline__ void a_ready(const pg8::Unit&) const {}
    __device__ __forceinline__ void done(const pg8::Unit&) const {}
    __device__ __forceinline__ void warm(const pg8::Unit& n, const char* nB, size_t hstep, LAS unsigned char* dummy, int tid) const {
#if WARM_B
        if (!(n.pm < 128 && (n.pm & 7) == 0)) return;
        const char* rowp = nB + (size_t)(tid >> 1) * (hstep >> 7);
        for (int ln = 2 + (tid & 1); ln < nlines; ln += 2) __builtin_amdgcn_global_load_lds((const unsigned*)(rowp + ln * 128), (LAS unsigned*)dummy, 4, 0, 0);
#endif
    }
};
typedef GroupedOrderT<false> GroupedOrder; typedef GroupedOrderT<true> GroupedGatherOrder;
struct CtxSplitOrder {
    static constexpr bool GATHER = false; static constexpr int AUX_B = 0, HALF_PM = HALF_CTX ? 128 : (1 << 30); static constexpr bool PF = PG8_PREFETCH;
    int G, c, KH;
    __device__ void init(int G_, int c_, int KH_) { G = G_; c = c_; KH = KH_; }
    __device__ bool next(int i, pg8::Unit& u) const {
        const int W = i * G + c; if (W >= NE * 4 * 2) return false;
        const int ks = W & 1, jn = (W >> 1) & 3, e = W >> 3;
        u.pm = 128 + e; u.pn = e * 4 + jn; u.ko = ks * KH; return true;
    }
    __device__ __forceinline__ void a_ready(const pg8::Unit&) const {}
    __device__ __forceinline__ void done(const pg8::Unit&) const {}
    __device__ __forceinline__ void warm(const pg8::Unit&, const char*, size_t, LAS unsigned char*, int) const {}
};

struct EpiProj {
    static constexpr bool PERM = true, AFTER_DRAIN = false;
    bf16 *VX, *VC, *UX, *UG;
    __device__ __forceinline__ void operator()(const f32x4 (&acc)[2][2][4][2], const pg8::Unit& u, int wr, int wc, int fr, int fq) const {
        const int rl0 = wr * 64 + fr, cl0 = wc * 32 + 8 * fq;
        if (u.pn >= 4) {
            bf16* base = ((u.pn < 6) ? UX : UG) + (size_t)(u.pm * 256 + rl0) * 512 + (u.pn & 1) * 256 + cl0;
#pragma unroll
            for (int ai = 0; ai < 2; ++ai)
#pragma unroll
                for (int m = 0; m < 4; ++m)
#pragma unroll
                    for (int bj = 0; bj < 2; ++bj) {
                        const f32x4 v0 = acc[ai][bj][m][0], v1 = acc[ai][bj][m][1];
                        *(u32x4*)(base + (size_t)(ai * 128 + m * 16) * 512 + bj * 128) = (u32x4){pk2(v0[0], v0[1]), pk2(v0[2], v0[3]), pk2(v1[0], v1[1]), pk2(v1[2], v1[3])};
                    }
        } else if (u.pm < 64) {
            const int ri = u.pn >> 1, b = u.pm >> 4, t0 = (u.pm & 15) * 256 + rl0, cb0 = ((u.pn & 1) * 256 + cl0) >> 2;
            bf16* base = VX + ((size_t)((b * 128 + cb0) * 2 + ri) * 4096 + t0) * 4;
#pragma unroll
            for (int ai = 0; ai < 2; ++ai)
#pragma unroll
                for (int m = 0; m < 4; ++m)
#pragma unroll
                    for (int bj = 0; bj < 2; ++bj) {
                        const f32x4 v0 = acc[ai][bj][m][0], v1 = acc[ai][bj][m][1];
                        bf16* p = base + (size_t)(bj * 32) * 2 * 4096 * 4 + (size_t)(ai * 128 + m * 16) * 4;
                        *(u32x2*)p = (u32x2){pk2(v0[0], v0[1]), pk2(v0[2], v0[3])};
                        *(u32x2*)(p + (size_t)2 * 4096 * 4) = (u32x2){pk2(v1[0], v1[1]), pk2(v1[2], v1[3])};
                    }
        } else {
            const int ri = u.pn >> 1, rc0 = (u.pm - 64) * 256 + rl0;
            bf16* base = VC + ((size_t)(ri * 512 + (u.pn & 1) * 256 + cl0)) * 256;
#pragma unroll
            for (int ai = 0; ai < 2; ++ai)
#pragma unroll
                for (int m = 0; m < 4; ++m) {
                    const int rc = rc0 + ai * 128 + m * 16, b = rc >> 8, t = rc & 255;
#pragma unroll
                    for (int bj = 0; bj < 2; ++bj) {
                        bf16* p = base + (size_t)(b * 2 * 512 + bj * 128) * 256 + t;
#pragma unroll
                        for (int n = 0; n < 2; ++n)
#pragma unroll
                            for (int i = 0; i < 4; ++i) p[(4 * n + i) * 256] = f2bf1(acc[ai][bj][m][n][i]);
                    }
                }
        }
    }
};
#if XBF16
struct EpiOut {
    static constexpr bool PERM = true, AFTER_DRAIN = false;
    bf16* X; const float* modl; float gs;
    __device__ __forceinline__ void operator()(const f32x4 (&acc)[2][2][4][2], const pg8::Unit& u, int wr, int wc, int fr, int fq) const {
        const int brow = (u.pm < 64) ? (u.pm >> 4) : 4;
        const int col0 = u.pn * 256 + wc * 32 + 8 * fq;
        const float* gp = modl + brow * 6144 + 2048 + col0;
        f32x4 gv[2][2];
#pragma unroll
        for (int bj = 0; bj < 2; ++bj)
#pragma unroll
            for (int n = 0; n < 2; ++n) gv[bj][n] = *(const f32x4*)(gp + bj * 128 + n * 4) * gs;
#pragma unroll
        for (int ai = 0; ai < 2; ++ai)
#pragma unroll
            for (int m = 0; m < 4; ++m) {
                bf16* rowp = X + (size_t)(u.pm * 256 + ai * 128 + wr * 64 + m * 16 + fr) * 1024 + col0;
#pragma unroll
                for (int bj = 0; bj < 2; ++bj) {
                    u32x4* p = (u32x4*)(rowp + bj * 128); const u32x4 xv = *p;
                    const f32x4 x0 = (f32x4){bflo(xv.x), bfhi(xv.x), bflo(xv.y), bfhi(xv.y)} + gv[bj][0] * acc[ai][bj][m][0];
                    const f32x4 x1 = (f32x4){bflo(xv.z), bfhi(xv.z), bflo(xv.w), bfhi(xv.w)} + gv[bj][1] * acc[ai][bj][m][1];
                    *p = (u32x4){pk2(x0[0], x0[1]), pk2(x0[2], x0[3]), pk2(x1[0], x1[1]), pk2(x1[2], x1[3])};
                }
            }
    }
};
#else
struct EpiOut {
    static constexpr bool PERM = false, AFTER_DRAIN = false;
    float* X; const float* modl; float gs;
    __device__ __forceinline__ void operator()(const f32x4 (&acc)[2][2][4][2], const pg8::Unit& u, int wr, int wc, int fr, int fq) const {
        const int brow = (u.pm < 64) ? (u.pm >> 4) : 4;
        const int col0 = u.pn * 256 + wc * 32 + 4 * fq;
        const float* gp = modl + brow * 6144 + 2048 + col0;
        f32x4 gv[2][2];
#pragma unroll
        for (int bj = 0; bj < 2; ++bj)
#pragma unroll
            for (int n = 0; n < 2; ++n) gv[bj][n] = *(const f32x4*)(gp + bj * 128 + n * 16) * gs;
#pragma unroll
        for (int ai = 0; ai < 2; ++ai)
#pragma unroll
            for (int m = 0; m < 4; ++m) {
                float* rowp = X + (size_t)(u.pm * 256 + ai * 128 + wr * 64 + m * 16 + fr) * 1024 + col0;
#pragma unroll
                for (int bj = 0; bj < 2; ++bj)
#pragma unroll
                    for (int n = 0; n < 2; ++n) { f32x4* p = (f32x4*)(rowp + bj * 128 + n * 16); const f32x4 xv = *p; *p = xv + gv[bj][n] * acc[ai][bj][m][n]; }
            }
    }
};
#endif
struct EpiG1 {
    static constexpr bool PERM = true, AFTER_DRAIN = false;
    bf16* HID; int TN;
    __device__ __forceinline__ void operator()(const f32x4 (&acc)[2][2][4][2], const pg8::Unit& u, int wr, int wc, int fr, int fq) const {
        const int col0 = (u.pn % TN) * 128 + wc * 32 + 8 * fq;
#pragma unroll
        for (int ai = 0; ai < 2; ++ai) { if (HALF_CTX && ai == 1 && u.pm >= 128) break;
#pragma unroll
            for (int m = 0; m < 4; ++m) {
                const int row = u.pm * 256 + ai * 128 + wr * 64 + m * 16 + fr;
                float h[8];
#pragma unroll
                for (int n = 0; n < 2; ++n)
#pragma unroll
                    for (int i = 0; i < 4; ++i) { const float g = acc[ai][0][m][n][i], up = acc[ai][1][m][n][i]; h[n * 4 + i] = g * up * __builtin_amdgcn_rcpf(1.0f + __builtin_amdgcn_exp2f(-1.4426950408889634f * g)); }
                *(u32x4*)(HID + (size_t)row * DFF + col0) = (u32x4){pk2(h[0], h[1]), pk2(h[2], h[3]), pk2(h[4], h[5]), pk2(h[6], h[7])};
            }
        }
    }
};
struct EpiG2 {
    static constexpr bool PERM = true, AFTER_DRAIN = false;
    bf16* YS; bf16* YS2; const float* SELG;
    __device__ __forceinline__ void operator()(const f32x4 (&acc)[2][2][4][2], const pg8::Unit& u, int wr, int wc, int fr, int fq) const {
        const int col0 = (u.pn & 3) * 256 + wc * 32 + 8 * fq;
        bf16* base = (u.ko == 0) ? YS : YS2 - (size_t)SLOTX * 1024;
#pragma unroll
        for (int ai = 0; ai < 2; ++ai) { if (HALF_CTX && ai == 1 && u.pm >= 128) break;
#pragma unroll
            for (int m = 0; m < 4; ++m) {
                const int row = u.pm * 256 + ai * 128 + wr * 64 + m * 16 + fr;
                const float g = SELG[row];
#pragma unroll
                for (int bj = 0; bj < 2; ++bj) {
                    const f32x4 v0 = acc[ai][bj][m][0] * g, v1 = acc[ai][bj][m][1] * g;
                    u32x4 w; w.x = pk2(v0[0], v0[1]); w.y = pk2(v0[2], v0[3]); w.z = pk2(v1[0], v1[1]); w.w = pk2(v1[2], v1[3]);
                    *(u32x4*)(base + (size_t)row * 1024 + col0 + bj * 128) = w;
                }
            }
        }
    }
};

typedef float f32x16 __attribute__((ext_vector_type(16)));
__device__ __forceinline__ void fold_item(const float* w_in_l, bf16* win_l, int kb, int g, int it, unsigned char* lds, int tid) {
    float* Wl = (float*)lds;
    float* tc = Wl + 32 * 129;
    float* tn = tc + 128;
    for (int i = tid; i < 1024; i += 512) { const int kk = i >> 5, c4 = (i & 31) * 4; const f32x4 v = *(const f32x4*)(w_in_l + (size_t)(kb * 64 + it * 32 + kk) * 1536 + g * 128 + c4);
        float* d = Wl + kk * 129 + c4; d[0] = v[0]; d[1] = v[1]; d[2] = v[2]; d[3] = v[3]; }
    if (tid < 128) { float s, c; sincospif((float)tid * (1.0f / 64.0f), &s, &c); tc[tid] = c * 0.08838834764831845f; tn[tid] = -s * 0.08838834764831845f; }
    __syncthreads();
    const int w = tid >> 6, lane = tid & 63, j = lane & 31, h = lane >> 5, cp = (32 * w + j) & 127;
    const float* tab = (w >> 2) ? tn : tc;
    const float* wrow = Wl + j * 129 + h;
    f32x16 acc;
#pragma unroll
    for (int r = 0; r < 16; ++r) acc[r] = 0.f;
    int idx = (h * cp) & 127;
#pragma unroll 8
    for (int s = 0; s < 64; ++s) {
        acc = __builtin_amdgcn_mfma_f32_32x32x2f32(wrow[2 * s], tab[idx], acc, 0, 0, 0);
        idx = (idx + 2 * cp) & 127;
    }
    bf16* dst = win_l + (size_t)((w >> 2) * 512 + g * 128 + cp) * 1024 + kb * 64 + it * 32 + 4 * h;
#pragma unroll
    for (int q = 0; q < 4; ++q) *(u32x2*)(dst + 8 * q) = (u32x2){pk2(acc[4 * q], acc[4 * q + 1]), pk2(acc[4 * q + 2], acc[4 * q + 3])};
    __syncthreads();
}
__device__ __forceinline__ void mod_item(const float* c_in, const float* cctx, const float* w_mod_l, const float* b_mod_l, float* mod_l, int jb, unsigned char* lds, int tid) {
    float* cond = (float*)lds;
    float* red = (float*)(lds + 20480);
    for (int i = tid; i < 5120; i += 512) { const float v = (i < 4096) ? c_in[i] : cctx[i - 4096]; cond[i] = v / (1.0f + expf(-v)); }
    __syncthreads();
    const int jq = tid & 15, kq = tid >> 4;
    f32x4 acc[5];
#pragma unroll
    for (int r = 0; r < 5; ++r) acc[r] = (f32x4){0.f, 0.f, 0.f, 0.f};
    const float* wp = w_mod_l + (size_t)(kq * 32) * 6144 + jb * 64 + jq * 4;
#pragma unroll 16
    for (int k = 0; k < 32; ++k) {
        const f32x4 w = __builtin_nontemporal_load((const f32x4*)(wp + (size_t)k * 6144));
#pragma unroll
        for (int r = 0; r < 5; ++r) acc[r] += w * cond[r * 1024 + kq * 32 + k];
    }
#pragma unroll
    for (int r = 0; r < 5; ++r) *(f32x4*)(red + ((kq * 5 + r) * 64 + jq * 4)) = acc[r];
    __syncthreads();
    if (tid < 320) { const int r = tid >> 6, col = tid & 63; float s = 0.f;
        for (int k2 = 0; k2 < 32; ++k2) s += red[(k2 * 5 + r) * 64 + col];
        mod_l[r * 6144 + jb * 64 + col] = s + b_mod_l[jb * 64 + col]; }
    __syncthreads();
}
__device__ __forceinline__ void tables_items(unsigned char* ws, const float* lru_wa, const float* lru_wi, int gi, int gn) {
    bf16* M1 = (bf16*)(ws + WS_M1); bf16* M3 = (bf16*)(ws + WS_M3); float* PE = (float*)(ws + WS_PE); bf16* GWT = (bf16*)(ws + WS_GWT);
    for (int idx = gi; idx < 128 * 128; idx += gn) {
        const int R = idx >> 7, Cc = idx & 127, ro = R >> 6, k1 = R & 63, ri = Cc >> 6, n1 = Cc & 63, mm = (n1 * k1) & 63;
        float s, c; sincospif((float)mm * (1.0f / 32.0f), &s, &c);
        const float v = (ro == ri) ? c : (ro == 0 ? s : -s);
        M1[idx] = f2bf1(v * 0.125f);
    }
    for (int idx = gi; idx < 64 * 128; idx += gn) {
        const int k2 = idx >> 7, Cc = idx & 127, ri = Cc >> 6, n2 = Cc & 63, mm = (n2 * k2) & 63;
        float s, c; sincospif((float)mm * (1.0f / 32.0f), &s, &c);
        M3[idx] = f2bf1((ri == 0 ? c : s) * 0.125f);
    }
    { bf16* MCT = (bf16*)(ws + WS_MCT);
      for (int idx = gi; idx < 256 * 512; idx += gn) {
        const int k = idx >> 9, Cc = idx & 511, ri = Cc >> 8, n = Cc & 255, mm = (n * k) & 255;
        float sn, cs; sincospif((float)mm * (1.0f / 128.0f), &sn, &cs);
        MCT[idx] = f2bf1((ri == 0 ? cs : sn) * 0.0625f);
      } }
    for (int idx = gi; idx < 64 * 512; idx += gn) {
        const int p = idx >> 9, j = idx & 511, jj = j & 255;
        const float om = 1.0f / powf(10000.0f, (float)jj * (1.0f / 256.0f));
        const float ang = (float)p * om;
        PE[idx] = (j < 256) ? sinf(ang) : cosf(ang);
    }
    for (int idx = gi; idx < 2 * 2 * 2 * 8 * 4096; idx += gn) {
        const int i = idx & 63, j = (idx >> 6) & 63, hd = (idx >> 12) & 7, mat = (idx >> 15) & 1, dir = (idx >> 16) & 1, l = idx >> 17;
        const float* src = mat ? lru_wi : lru_wa;
        GWT[idx] = f2bf1(src[((size_t)((l * 2 + dir) * 8 + hd) * 64 + i) * 64 + j]);
    }
}

__device__ __forceinline__ void row_store_bf16(bf16* dst, const f32x4 (&v)[4], int lane) {
#pragma unroll
    for (int j = 0; j < 4; ++j) *(u32x2*)(dst + 4 * lane + 256 * j) = (u32x2){pk2(v[j][0], v[j][1]), pk2(v[j][2], v[j][3])};
}
__device__ __forceinline__ void row_store_bf16_kt(bf16* dst, const f32x4 (&v)[4], int lane) {
#pragma unroll
    for (int j = 0; j < 4; ++j) *(u32x2*)(dst + (size_t)((lane >> 4) + 4 * j) * ((size_t)PG8_GATHER_KT_ROWS * 64) + 4 * (lane & 15)) = (u32x2){pk2(v[j][0], v[j][1]), pk2(v[j][2], v[j][3])};
}
constexpr int HNRS = PG8_GATHER_KT_ROWS ? 64 : 1024;
#if XBF16
typedef bf16 xres_t;
__device__ __forceinline__ void xrow_load(const xres_t* p, int lane, f32x4 (&v)[4]) {
#pragma unroll
    for (int j = 0; j < 4; ++j) { const u32x2 d = __builtin_nontemporal_load((const u32x2*)(p + 4 * lane + 256 * j)); v[j] = (f32x4){bflo(d.x), bfhi(d.x), bflo(d.y), bfhi(d.y)}; }
}
__device__ __forceinline__ void xrow_store(xres_t* p, int lane, const f32x4 (&v)[4]) { row_store_bf16(p, v, lane); }
#else
typedef float xres_t;
__device__ __forceinline__ void xrow_load(const xres_t* p, int lane, f32x4 (&v)[4]) {
#pragma unroll
    for (int j = 0; j < 4; ++j) v[j] = *(const f32x4*)(p + 4 * lane + 256 * j);
}
__device__ __forceinline__ void xrow_store(xres_t* p, int lane, const f32x4 (&v)[4]) {
#pragma unroll
    for (int j = 0; j < 4; ++j) *(f32x4*)(p + 4 * lane + 256 * j) = v[j];
}
#endif
__device__ __forceinline__ float row_rstd(const f32x4 (&v)[4]) {
    float ss = 0.f;
#pragma unroll
    for (int j = 0; j < 4; ++j) ss += (v[j][0] * v[j][0] + v[j][1] * v[j][1]) + (v[j][2] * v[j][2] + v[j][3] * v[j][3]);
    ss = wave_sum(ss);
    return 1.0f / sqrtf(ss * (1.0f / 1024.0f) + 1e-6f);
}
__device__ __forceinline__ void load_modAB(const float* gain, const float* modl, int r, int osh, int osc, int lane, f32x4 (&A)[4], f32x4 (&Bv)[4]) {
#pragma unroll
    for (int j = 0; j < 4; ++j) {
        const int c = 4 * lane + 256 * j;
        const f32x4 g = *(const f32x4*)(gain + c), sc = *(const f32x4*)(modl + r * 6144 + osc + c);
        A[j] = g * (sc + 1.0f); Bv[j] = *(const f32x4*)(modl + r * 6144 + osh + c);
    }
}

#ifndef FOUR_TR
#define FOUR_TR 1
#endif
__device__ __forceinline__ int xz_addr(int ri, int a, int ch, int i) { return (ri * 64 + a) * 528 + ch * 128 + i * 2; }
__device__ __forceinline__ void fourier_unit(const bf16* VX, const bf16* M1g, const bf16* M3g, bf16* MIX, int b, int cb, const ConvCtx cc, int cslot, LAS unsigned char* lds, int tid) {
    const int lane = tid & 63, wv = tid >> 6;
    f32x4 cv[8]; CItem ci = citem_gu(cc, cc.nA + (cslot * 8 + wv) * 2);
    tr_load(ci.src, ci.ldn, ci.kbase, ci.nbase, lane, cv);
#if FOUR_TR
    LAS unsigned char* RA = lds;
    LAS unsigned char* RB = lds + 73728;
    typedef short s16x4 __attribute__((ext_vector_type(4)));
    {
        u32x4 dv[2][4];
#pragma unroll
        for (int ri = 0; ri < 2; ++ri) {
            const bf16* src = VX + ((size_t)((b * 128 + cb) * 2 + ri) * 4096) * 4;
#pragma unroll
            for (int it = 0; it < 4; ++it) dv[ri][it] = __builtin_nontemporal_load((const u32x4*)(src + (size_t)(tid + 512 * it) * 8));
        }
        for (int i = tid; i < 2048; i += 512) *(LAS u32x4*)(RB + (i >> 4) * 272 + (i & 15) * 16) = *(const u32x4*)(M1g + (size_t)i * 8);
        for (int i = tid; i < 1024; i += 512) *(LAS u32x4*)(RB + 34816 + (i >> 4) * 272 + (i & 15) * 16) = *(const u32x4*)(M3g + (size_t)i * 8);
#pragma unroll
        for (int ri = 0; ri < 2; ++ri)
#pragma unroll
            for (int it = 0; it < 4; ++it) { const int pp = tid + 512 * it;
                *(LAS u32x4*)(RA + ri * 36864 + (pp >> 5) * 576 + ((2 * pp) & 63) * 8) = dv[ri][it]; }
    }
    __syncthreads();
    tr_store(cv, ci.dst, ci.Kd, ci.kbase, ci.drow0, lane);
    const int c32 = lane & 31, h = lane >> 5, n2l = 8 * wv + (c32 >> 2), chl = c32 & 3;
    const int ch = wv >> 1, nb2 = 32 * (wv & 1);
    f32x16 acc[4];
#pragma unroll
    for (int mt = 0; mt < 4; ++mt)
#pragma unroll
        for (int r = 0; r < 16; ++r) acc[mt][r] = 0.f;
    {
        const unsigned vb0 = (unsigned)(size_t)RA + (unsigned)((8 * h + ((lane >> 2) & 3)) * 576 + (32 * wv + 16 * ((lane >> 4) & 1) + 4 * (lane & 3)) * 2), vb1 = vb0 + 36864u;
        s16x4 t0[8], t1[8];
#define FTR8(o, a) asm volatile("ds_read_b64_tr_b16 %0, %8\n\tds_read_b64_tr_b16 %1, %8 offset:2304\n\tds_read_b64_tr_b16 %2, %8 offset:9216\n\tds_read_b64_tr_b16 %3, %8 offset:11520\n\t" \
                                "ds_read_b64_tr_b16 %4, %8 offset:18432\n\tds_read_b64_tr_b16 %5, %8 offset:20736\n\tds_read_b64_tr_b16 %6, %8 offset:27648\n\tds_read_b64_tr_b16 %7, %8 offset:29952\n\t" \
                                "s_waitcnt lgkmcnt(0)" : "=&v"(o[0]), "=&v"(o[1]), "=&v"(o[2]), "=&v"(o[3]), "=&v"(o[4]), "=&v"(o[5]), "=&v"(o[6]), "=&v"(o[7]) : "v"(a) : "memory")
        FTR8(t0, vb0); FTR8(t1, vb1);
#undef FTR8
        __builtin_amdgcn_sched_barrier(0);
#pragma unroll
        for (int s = 0; s < 8; ++s) {
            const s16x4 lo_ = (s < 4) ? t0[2 * (s & 3)] : t1[2 * (s & 3)], hi_ = (s < 4) ? t0[2 * (s & 3) + 1] : t1[2 * (s & 3) + 1];
            const bf16x8 bfr = (bf16x8){lo_[0], lo_[1], lo_[2], lo_[3], hi_[0], hi_[1], hi_[2], hi_[3]};
#pragma unroll
            for (int mt = 0; mt < 4; ++mt) {
                const bf16x8 afr = *(LAS bf16x8*)(RB + (32 * mt + c32) * 272 + (16 * s + 8 * h) * 2);
                acc[mt] = __builtin_amdgcn_mfma_f32_32x32x16_bf16(afr, bfr, acc[mt], 0, 0, 0);
            }
        }
    }
#else
    LAS unsigned char* RA = lds;
    LAS unsigned char* RB = lds + 67584;
    for (int ri = 0; ri < 2; ++ri) {
        const bf16* src = VX + ((size_t)((b * 128 + cb) * 2 + ri) * 4096) * 4;
#pragma unroll
        for (int it = 0; it < 4; ++it) {
            const int p = tid + 512 * it;
            const u32x4 d = __builtin_nontemporal_load((const u32x4*)(src + (size_t)p * 8));
            const int n1 = p >> 5, n2 = (2 * p) & 63;
            LAS unsigned char* q = RB + (n1 * 65 + n2) * 8;
            *(LAS u32x2*)q = (u32x2){d.x, d.y}; *(LAS u32x2*)(q + 8) = (u32x2){d.z, d.w};
        }
        __syncthreads();
#pragma unroll
        for (int it = 0; it < 8; ++it) {
            const int n2 = wv + 8 * it;
            const u32x2 d = *(LAS u32x2*)(RB + (lane * 65 + n2) * 8);
            *(LAS unsigned short*)(RA + xz_addr(ri, n2, 0, lane)) = (unsigned short)(d.x & 0xffffu);
            *(LAS unsigned short*)(RA + xz_addr(ri, n2, 1, lane)) = (unsigned short)(d.x >> 16);
            *(LAS unsigned short*)(RA + xz_addr(ri, n2, 2, lane)) = (unsigned short)(d.y & 0xffffu);
            *(LAS unsigned short*)(RA + xz_addr(ri, n2, 3, lane)) = (unsigned short)(d.y >> 16);
        }
        __syncthreads();
    }
    tr_store(cv, ci.dst, ci.Kd, ci.kbase, ci.drow0, lane);
    for (int i = tid; i < 2048; i += 512) *(LAS u32x4*)(RB + (i >> 4) * 272 + (i & 15) * 16) = *(const u32x4*)(M1g + (size_t)i * 8);
    for (int i = tid; i < 1024; i += 512) *(LAS u32x4*)(RB + 34816 + (i >> 4) * 272 + (i & 15) * 16) = *(const u32x4*)(M3g + (size_t)i * 8);
    __syncthreads();
    const int ch = wv >> 1, nb2 = 32 * (wv & 1), c32 = lane & 31, h = lane >> 5, chl = ch;
    f32x16 acc[4];
#pragma unroll
    for (int mt = 0; mt < 4; ++mt)
#pragma unroll
        for (int r = 0; r < 16; ++r) acc[mt][r] = 0.f;
#pragma unroll
    for (int s = 0; s < 8; ++s) {
        const bf16x8 bfr = *(LAS bf16x8*)(RA + xz_addr(s >> 2, nb2 + c32, ch, 16 * (s & 3) + 8 * h));
#pragma unroll
        for (int mt = 0; mt < 4; ++mt) {
            const bf16x8 afr = *(LAS bf16x8*)(RB + (32 * mt + c32) * 272 + (16 * s + 8 * h) * 2);
            acc[mt] = __builtin_amdgcn_mfma_f32_32x32x16_bf16(afr, bfr, acc[mt], 0, 0, 0);
        }
    }
#endif
    __syncthreads();
    {
#if FOUR_TR
        const int n2 = n2l;
#else
        const int n2 = nb2 + c32;
#endif
        float w1s, w1c, w8s, w8c, w32s, w32c, s0s, s0c;
        sincospif((float)n2 * (1.0f / 2048.0f), &w1s, &w1c);
        sincospif((float)((8 * n2) & 4095) * (1.0f / 2048.0f), &w8s, &w8c);
        sincospif((float)((32 * n2) & 4095) * (1.0f / 2048.0f), &w32s, &w32c);
        sincospif((float)((4 * h * n2) & 4095) * (1.0f / 2048.0f), &s0s, &s0c);
        float bc = s0c, bs = s0s;
#pragma unroll
        for (int mt = 0; mt < 2; ++mt) {
            float ic = bc, is = bs;
#pragma unroll
            for (int i = 0; i < 4; ++i) {
                float jc = ic, js = is;
#pragma unroll
                for (int j = 0; j < 4; ++j) {
                    const int r = 4 * i + j, k1 = 32 * mt + j + 8 * i + 4 * h;
                    const float ar = acc[mt][r], ai = acc[mt + 2][r];
                    const float zr = ar * jc + ai * js, zi = ai * jc - ar * js;
                    *(LAS unsigned short*)(RA + xz_addr(0, k1, FOUR_TR ? chl : ch, n2)) = f2bf1(zr);
                    *(LAS unsigned short*)(RA + xz_addr(1, k1, FOUR_TR ? chl : ch, n2)) = f2bf1(zi);
                    const float tc_ = jc * w1c - js * w1s, ts_ = js * w1c + jc * w1s; jc = tc_; js = ts_;
                }
                const float tc_ = ic * w8c - is * w8s, ts_ = is * w8c + ic * w8s; ic = tc_; is = ts_;
            }
            const float tc_ = bc * w32c - bs * w32s, ts_ = bs * w32c + bc * w32s; bc = tc_; bs = ts_;
        }
    }
    __syncthreads();
    ci = citem_gu(cc, cc.nA + (cslot * 8 + wv) * 2 + 1);
    tr_load(ci.src, ci.ldn, ci.kbase, ci.nbase, lane, cv);
    f32x16 a3[2];
#pragma unroll
    for (int mt = 0; mt < 2; ++mt)
#pragma unroll
        for (int r = 0; r < 16; ++r) a3[mt][r] = 0.f;
    {
        const int k1 = nb2 + c32;
#pragma unroll
        for (int s = 0; s < 8; ++s) {
            const bf16x8 bfr = *(LAS bf16x8*)(RA + xz_addr(s >> 2, k1, ch, 16 * (s & 3) + 8 * h));
#pragma unroll
            for (int mt = 0; mt < 2; ++mt) {
                const bf16x8 afr = *(LAS bf16x8*)(RB + 34816 + (32 * mt + c32) * 272 + (16 * s + 8 * h) * 2);
                a3[mt] = __builtin_amdgcn_mfma_f32_32x32x16_bf16(afr, bfr, a3[mt], 0, 0, 0);
            }
        }
        __syncthreads();
#pragma unroll
        for (int mt = 0; mt < 2; ++mt)
#pragma unroll
            for (int r = 0; r < 16; ++r) {
                const int k2 = 32 * mt + (r & 3) + 8 * (r >> 2) + 4 * h, tok = k1 + 64 * k2;
                *(LAS unsigned short*)(RA + (tok * 4 + ch) * 2) = f2bf1(a3[mt][r]);
            }
    }
    __syncthreads();
#pragma unroll
    for (int it = 0; it < 8; ++it) {
        const int tok = tid + 512 * it;
        *(u32x2*)(MIX + (size_t)(b * 4096 + tok) * 1024 + cb * 4) = *(LAS u32x2*)(RA + tok * 8);
    }
    tr_store(cv, ci.dst, ci.Kd, ci.kbase, ci.drow0, lane);
    __syncthreads();
}
__device__ __forceinline__ void fourier_ctx_unit(const bf16* VCt, const bf16* MCT, bf16* MIX, int b, int cb, int tid) {
    const int lane = tid & 63, wv = tid >> 6, c32 = lane & 31, h = lane >> 5;
    f32x16 acc;
#pragma unroll
    for (int r = 0; r < 16; ++r) acc[r] = 0.f;
    const bf16* ap = MCT + (size_t)(32 * wv + c32) * 512 + 8 * h;
    const bf16* bp = VCt + ((size_t)(b * 2) * 512 + cb * 32 + c32) * 256 + 8 * h;
#pragma unroll 8
    for (int s = 0; s < 32; ++s) {
        const int kidx = 16 * s, ri = kidx >> 8, n = kidx & 255;
        const bf16x8 afr = *(const bf16x8*)(ap + kidx);
        const bf16x8 bfr = *(const bf16x8*)(bp + (size_t)ri * 512 * 256 + n);
        acc = __builtin_amdgcn_mfma_f32_32x32x16_bf16(afr, bfr, acc, 0, 0, 0);
    }
#pragma unroll
    for (int r = 0; r < 16; ++r) {
        const int k = 32 * wv + (r & 3) + 8 * (r >> 2) + 4 * h;
        MIX[(size_t)(MX + b * 256 + k) * 1024 + cb * 32 + c32] = f2bf1(acc[r]);
    }
}

__device__ __forceinline__ float fexp2(float x) { return __builtin_amdgcn_exp2f(x); }
__device__ __forceinline__ float frcp(float x) { return __builtin_amdgcn_rcpf(x); }
__device__ __forceinline__ float fsigmoid(float x) { return frcp(1.0f + fexp2(-1.4426950408889634f * x)); }
__device__ __forceinline__ void scan_unit_geom(int p, int& s, int& qc, int& nset, int& rowbase, int& t0) {
    s = p / NCHUNK; qc = p % NCHUNK;
    nset = (qc < 4) ? 256 : 4096; rowbase = (qc < 4) ? MX + s * 256 : s * 4096; t0 = (qc < 4) ? qc * 64 : (qc - 4) * 64;
}
__device__ __forceinline__ void scan_load_raw(const bf16* UX, int p, int hd, int tt, int c8, u32x4 (&raw)[4]) {
    int s, qc, nset, rowbase, t0; scan_unit_geom(p, s, qc, nset, rowbase, t0);
#pragma unroll
    for (int k = 0; k < 4; ++k) {
        const int t = t0 + tt - 1 + k;
        raw[k] = (u32x4){0u, 0u, 0u, 0u};
        if (t >= 0 && t < nset) raw[k] = *(const u32x4*)(UX + (size_t)(rowbase + t) * 512 + hd * 64 + c8);
    }
}
template <bool FINAL>
__device__ __forceinline__ void scan_phase(const bf16* UX, const bf16* UG, bf16* MIX, const bf16* GWT, float* SUMM, const float* conv_w_l, const float* conv_b_l,
                                           const float* ba_l, const float* bi_l, const float* lam_l, int l, int w, bool skip_ctx, const ConvCtx cc, LAS unsigned char* lds, int tid) {
    const int lane = tid & 63, wv = tid >> 6, dir = wv >> 2, cg = wv & 3, hd = w >> 5;
    const int fr = lane & 15, q = lane >> 4;
    LAS float* XC32 = (LAS float*)lds;
    LAS unsigned char* XCb = lds + 16640;
    LAS float* Y = (LAS float*)(lds + 16640 + 9216);
    bf16x8 bfr[2][2];
#pragma unroll
    for (int mat = 0; mat < 2; ++mat)
#pragma unroll
        for (int ks = 0; ks < 2; ++ks) bfr[mat][ks] = *(const bf16x8*)(GWT + (size_t)((((l * 2 + dir) * 2 + mat) * 8 + hd) * 64 + 16 * cg + fr) * 64 + 32 * ks + 8 * q);
    const int chn = hd * 64 + 16 * cg + fr;
    const float ba_ = ba_l[dir * 512 + chn], bi_ = bi_l[dir * 512 + chn];
    const float cl2 = -8.0f * log1pf(expf(-lam_l[dir * 512 + chn])) * 1.4426950408889634f;
    const int tt = tid >> 3, c8 = (tid & 7) * 8;
    LAS float* CW = (LAS float*)(lds + 16640 + 9216 + 33280);
    if (tid < 320) CW[tid] = (tid < 256) ? conv_w_l[(tid >> 6) * 512 + hd * 64 + (tid & 63)] : conv_b_l[hd * 64 + (tid - 256)];
    __syncthreads();
    const int pstep = 32, pend = NB * NCHUNK;
    int p = (w & 31);
    if (skip_ctx) while (p < pend && (p % NCHUNK) < 4) p += pstep;
    u32x4 raw[4];
    if (p < pend) scan_load_raw(UX, p, hd, tt, c8, raw);
    int iter = 0;
    f32x4 cvA[8], cvB[8]; CItem ciA, ciB; bool onA = false, onB = false;
    while (p < pend) {
        int s, qc, nset, rowbase, t0; scan_unit_geom(p, s, qc, nset, rowbase, t0);
        if (onA) tr_store(cvA, ciA.dst, ciA.Kd, ciA.kbase, ciA.drow0, lane);
        if (onB) tr_store(cvB, ciB.dst, ciB.Kd, ciB.kbase, ciB.drow0, lane);
        int pn = p + pstep;
        if (skip_ctx) while (pn < pend && (pn % NCHUNK) < 4) pn += pstep;
        __syncthreads();
        {
            float x[8];
            { const f32x4 b0 = *(LAS f32x4*)(CW + 256 + c8), b1 = *(LAS f32x4*)(CW + 256 + c8 + 4);
#pragma unroll
              for (int i = 0; i < 4; ++i) { x[i] = b0[i]; x[4 + i] = b1[i]; } }
#pragma unroll
            for (int k = 0; k < 4; ++k) {
                const unsigned rw[4] = {raw[k].x, raw[k].y, raw[k].z, raw[k].w};
                const f32x4 w0 = *(LAS f32x4*)(CW + k * 64 + c8), w1 = *(LAS f32x4*)(CW + k * 64 + c8 + 4);
#pragma unroll
                for (int i = 0; i < 8; ++i) x[i] += ((i < 4) ? w0[i & 3] : w1[i & 3]) * ((i & 1) ? bfhi(rw[i >> 1]) : bflo(rw[i >> 1]));
            }
#pragma unroll
            for (int i = 0; i < 8; ++i) XC32[tt * 65 + c8 + i] = x[i];
            *(LAS u32x4*)(XCb + tt * 144 + c8 * 2) = (u32x4){pk2(x[0], x[1]), pk2(x[2], x[3]), pk2(x[4], x[5]), pk2(x[6], x[7])};
        }
        u32x4 ugv = (u32x4){0u, 0u, 0u, 0u};
        if (FINAL) ugv = __builtin_nontemporal_load((const u32x4*)(UG + (size_t)(rowbase + t0 + tt) * 512 + hd * 64 + c8));
        if (pn < pend) scan_load_raw(UX, pn, hd, tt, c8, raw);
        { const int slot = (iter * 256 + w) * 8 + wv; ++iter;
          onA = conv_pick(cc, slot, 0, ciA); if (onA) tr_load(ciA.src, ciA.ldn, ciA.kbase, ciA.nbase, lane, cvA);
          onB = conv_pick(cc, slot, 1, ciB); if (onB) tr_load(ciB.src, ciB.ldn, ciB.kbase, ciB.nbase, lane, cvB); }
        __syncthreads();
        f32x4 ga[4], gi4[4];
#pragma unroll
        for (int m = 0; m < 4; ++m) {
            ga[m] = (f32x4){0.f, 0.f, 0.f, 0.f}; gi4[m] = (f32x4){0.f, 0.f, 0.f, 0.f};
            const int tokA = 16 * (fr >> 2) + 4 * m + (fr & 3);
#pragma unroll
            for (int ks = 0; ks < 2; ++ks) {
                const bf16x8 afr = *(LAS bf16x8*)(XCb + tokA * 144 + (32 * ks + 8 * q) * 2);
                ga[m] = __builtin_amdgcn_mfma_f32_16x16x32_bf16(afr, bfr[0][ks], ga[m], 0, 0, 0);
                gi4[m] = __builtin_amdgcn_mfma_f32_16x16x32_bf16(afr, bfr[1][ks], gi4[m], 0, 0, 0);
            }
        }
        float av[16], dv[16];
#pragma unroll
        for (int m = 0; m < 4; ++m)
#pragma unroll
            for (int j = 0; j < 4; ++j) {
                const int tau = 4 * m + j, T = 16 * q + tau;
                const float r = fsigmoid(ga[m][j] + ba_);
                const float gg = fsigmoid(gi4[m][j] + bi_);
                const float a = fexp2(cl2 * r);
                const float xcv = XC32[T * 65 + 16 * cg + fr];
                av[tau] = a; dv[tau] = __builtin_amdgcn_sqrtf(fmaxf(fmaf(-a, a, 1.0f), 0.f)) * gg * xcv;
            }
        float P = 1.f, H = 0.f;
        if (dir == 0) {
#pragma unroll
            for (int tau = 0; tau < 16; ++tau) { H = av[tau] * H + dv[tau]; P *= av[tau]; }
        } else {
#pragma unroll
            for (int tau = 15; tau >= 0; --tau) { H = av[tau] * H + dv[tau]; P *= av[tau]; }
        }
        float Pq[4], Hq[4];
#pragma unroll
        for (int qq = 0; qq < 4; ++qq) { Pq[qq] = __shfl(P, fr + 16 * qq); Hq[qq] = __shfl(H, fr + 16 * qq); }
        if (!FINAL) {
            float A = 1.f, Hc = 0.f;
            if (dir == 0) {
#pragma unroll
                for (int qq = 0; qq < 4; ++qq) { Hc = Pq[qq] * Hc + Hq[qq]; A *= Pq[qq]; }
            } else {
#pragma unroll
                for (int qq = 3; qq >= 0; --qq) { Hc = Pq[qq] * Hc + Hq[qq]; A *= Pq[qq]; }
            }
            if (q == 0) *(f32x2*)(SUMM + ((size_t)((s * NCHUNK + qc) * 2 + dir) * 512 + chn) * 2) = (f32x2){A, Hc};
        } else {
            const int nctx = (dir == 0) ? 0 : ((qc < 4) ? 3 - qc : 4);
            const int L = (dir == 0) ? qc : ((qc < 4) ? 3 - qc : 4 + (NCHUNK - 1 - qc));
            const int Lq = (L + 3) >> 2, pos0 = q * Lq, pos1 = min(L, pos0 + Lq);
            const float* sb = SUMM + ((size_t)(s * NCHUNK) * 2 + dir) * 512 * 2 + chn * 2;
            float FA = 1.f, FH = 0.f;
            for (int pos = pos0; pos < pos1; pos += 4) {
                f32x2 ah[4];
#pragma unroll
                for (int i = 0; i < 4; ++i) {
                    const int pp = pos + i; ah[i] = (f32x2){1.f, 0.f};
                    if (pp < pos1) { const int c = (dir == 0) ? pp : (pp < nctx ? 3 - pp : (NCHUNK - 1) - (pp - nctx)); ah[i] = *(const f32x2*)(sb + (size_t)c * 2048); }
                }
#pragma unroll
                for (int i = 0; i < 4; ++i) { FH = ah[i][0] * FH + ah[i][1]; FA *= ah[i][0]; }
            }
            float C = 0.f;
#pragma unroll
            for (int g = 0; g < 4; ++g) { const float ga_ = __shfl(FA, fr + 16 * g), gh_ = __shfl(FH, fr + 16 * g); C = ga_ * C + gh_; }
            float h = C;
            if (dir == 0) {
#pragma unroll
                for (int qq = 0; qq < 3; ++qq) if (qq < q) h = Pq[qq] * h + Hq[qq];
#pragma unroll
                for (int tau = 0; tau < 16; ++tau) { h = av[tau] * h + dv[tau]; Y[(16 * q + tau) * 65 + 16 * cg + fr] = h; }
            } else {
#pragma unroll
                for (int qq = 3; qq >= 1; --qq) if (qq > q) h = Pq[qq] * h + Hq[qq];
#pragma unroll
                for (int tau = 15; tau >= 0; --tau) { h = av[tau] * h + dv[tau]; Y[64 * 65 + (16 * q + tau) * 65 + 16 * cg + fr] = h; }
            }
            __syncthreads();
            const size_t row = (size_t)(rowbase + t0 + tt);
            const unsigned ugw[4] = {ugv.x, ugv.y, ugv.z, ugv.w};
            float o[8];
#pragma unroll
            for (int i = 0; i < 8; ++i) {
                const float x = (i & 1) ? bfhi(ugw[i >> 1]) : bflo(ugw[i >> 1]);
                const float z = 0.7978845608028654f * (x + 0.044715f * x * x * x);
                const float th = 1.0f - 2.0f * frcp(1.0f + fexp2(2.8853900817779268f * z));
                const float yv = Y[tt * 65 + c8 + i] + Y[64 * 65 + tt * 65 + c8 + i];
                o[i] = yv * 0.5f * x * (1.0f + th);
            }
            u32x4 ow; ow.x = pk2(o[0], o[1]); ow.y = pk2(o[2], o[3]); ow.z = pk2(o[4], o[5]); ow.w = pk2(o[6], o[7]);
            *(u32x4*)(MIX + row * 1024 + 512 + hd * 64 + c8) = ow;
        }
        p = pn;
    }
    for (; iter <= 9; ++iter) {
        if (onA) tr_store(cvA, ciA.dst, ciA.Kd, ciA.kbase, ciA.drow0, lane);
        if (onB) tr_store(cvB, ciB.dst, ciB.Kd, ciB.kbase, ciB.drow0, lane);
        onA = false; onB = false;
        if (iter < 9) { const int slot = (iter * 256 + w) * 8 + wv;
          onA = conv_pick(cc, slot, 0, ciA); if (onA) tr_load(ciA.src, ciA.ldn, ciA.kbase, ciA.nbase, lane, cvA);
          onB = conv_pick(cc, slot, 1, ciB); if (onB) tr_load(ciB.src, ciB.ldn, ciB.kbase, ciB.nbase, lane, cvB); }
    }
    __syncthreads();
}

__device__ __forceinline__ int wr_addr(int c) { return c * 64 + (c >> 2) * 16; }
template <bool HALF> __device__ __forceinline__ void router_finish(const f32x4 (&lg)[4], float* affrow, int lane) {
    float t8[8], t4[4], t2[2], lgt;
    {
        const bool b0 = lane & 1, b1 = lane & 2, b2 = lane & 4, b3 = lane & 8;
#pragma unroll
        for (int k = 0; k < 8; ++k) { const float keep = b0 ? lg[(2 * k + 1) >> 2][(2 * k + 1) & 3] : lg[(2 * k) >> 2][(2 * k) & 3], send = b0 ? lg[(2 * k) >> 2][(2 * k) & 3] : lg[(2 * k + 1) >> 2][(2 * k + 1) & 3];
            t8[k] = keep + (XLANE_VALU ? xl_xor1(send) : __shfl_xor(send, 1)); }
#pragma unroll
        for (int k = 0; k < 4; ++k) { const float keep = b1 ? t8[2 * k + 1] : t8[2 * k], send = b1 ? t8[2 * k] : t8[2 * k + 1]; t4[k] = keep + (XLANE_VALU ? xl_xor2(send) : __shfl_xor(send, 2)); }
#pragma unroll
        for (int k = 0; k < 2; ++k) { const float keep = b2 ? t4[2 * k + 1] : t4[2 * k], send = b2 ? t4[2 * k] : t4[2 * k + 1]; t2[k] = keep + __shfl_xor(send, 4); }
        { const float keep = b3 ? t2[1] : t2[0], send = b3 ? t2[0] : t2[1]; lgt = keep + __shfl_xor(send, 8); }
        if (XLANE_VALU) { lgt += xl_xor16(lgt, lane); if (!HALF) lgt += xl_xor32(lgt, lane); } else { lgt += __shfl_xor(lgt, 16); if (!HALF) lgt += __shfl_xor(lgt, 32); }
    }
    float mx = lgt;
    if (XLANE_VALU) mx = row16_max(mx); else {
#pragma unroll
    for (int o = 1; o < 16; o <<= 1) mx = fmaxf(mx, __shfl_xor(mx, o)); }
    const float mine = expf(lgt - mx);
    float sum = mine;
    if (XLANE_VALU) sum = row16_sum(sum); else {
#pragma unroll
    for (int o = 1; o < 16; o <<= 1) sum += __shfl_xor(sum, o); }
    if ((lane & 31) < 16) { if (HALF || lane < 16) affrow[lane & 15] = mine / sum; }
}
__device__ __forceinline__ void n2r_prep(const xres_t* x, bf16* h, const f32x4 (&A)[4], const f32x4 (&Bv)[4], int lane, f32x4 (&v)[4]) {
    xrow_load(x, lane, v);
    const float rstd = row_rstd(v);
#pragma unroll
    for (int j = 0; j < 4; ++j) v[j] = v[j] * rstd * A[j] + Bv[j];
    if (PG8_GATHER_KT_ROWS) row_store_bf16_kt(h, v, lane); else row_store_bf16(h, v, lane);
}
template <int NR>
__device__ __forceinline__ void norm2_router_rows(const xres_t* x0, bf16* h0, float* aff0, const f32x4 (&A)[4], const f32x4 (&Bv)[4], const unsigned char* WR, int lane) {
    f32x4 va[4], vb[4], la[4], lb[4];
    n2r_prep(x0, h0, A, Bv, lane, va);
    if (NR == 2) n2r_prep(x0 + 1024, h0 + HNRS, A, Bv, lane, vb);
#pragma unroll
    for (int e4 = 0; e4 < 4; ++e4) { la[e4] = (f32x4){0.f, 0.f, 0.f, 0.f}; lb[e4] = (f32x4){0.f, 0.f, 0.f, 0.f}; }
    int zoff = 0;
#pragma unroll
    for (int j = 0; j < 4; ++j)
#pragma unroll
        for (int i = 0; i < 4; ++i) {
            const int c = 4 * lane + 256 * j + i;
            if (i == 0) asm volatile("" : "+v"(zoff), "+v"(la[0]));
            const unsigned char* wp = WR + wr_addr(c) + zoff;
#pragma unroll
            for (int e4 = 0; e4 < 4; ++e4) { const f32x4 w = *(const f32x4*)(wp + 16 * e4); la[e4] += w * va[j][i]; if (NR == 2) lb[e4] += w * vb[j][i]; }
        }
    if (NR == 2) {
        const bool hi = lane >= 32;
        f32x4 m[4];
#pragma unroll
        for (int e4 = 0; e4 < 4; ++e4)
#pragma unroll
            for (int i = 0; i < 4; ++i) { const float keep = hi ? lb[e4][i] : la[e4][i], send = hi ? la[e4][i] : lb[e4][i]; m[e4][i] = keep + (XLANE_VALU ? xl_xor32(send, lane) : __shfl_xor(send, 32)); }
        router_finish<true>(m, aff0 + (hi ? 16 : 0), lane);
    } else router_finish<false>(la, aff0, lane);
}

__device__ __forceinline__ unsigned block_excl_scan(unsigned v, unsigned* wt, int tid) {
    const int lane = tid & 63, wv = tid >> 6;
    unsigned inc = v;
#if SCAN_DPP
    {
        const int x = (int)v;
        int t = x;
        t += __builtin_amdgcn_update_dpp(0, x, 0x111, 0xF, 0xF, true);
        t += __builtin_amdgcn_update_dpp(0, x, 0x112, 0xF, 0xF, true);
        t += __builtin_amdgcn_update_dpp(0, x, 0x113, 0xF, 0xF, true);
        t += __builtin_amdgcn_update_dpp(0, t, 0x114, 0xF, 0xE, true);
        t += __builtin_amdgcn_update_dpp(0, t, 0x118, 0xF, 0xC, true);
        t += __builtin_amdgcn_update_dpp(0, t, 0x142, 0xA, 0xF, true);
        t += __builtin_amdgcn_update_dpp(0, t, 0x143, 0xC, 0xF, true);
        inc = (unsigned)t;
    }
#else
#pragma unroll
    for (int o = 1; o < 64; o <<= 1) { const unsigned t = __shfl_up(inc, o); if (lane >= o) inc += t; }
#endif
    if (lane == 63) wt[wv] = inc;
    __syncthreads();
    unsigned base = 0;
#pragma unroll
    for (int k = 0; k < 8; ++k) if (k < wv) base += wt[k];
    __syncthreads();
    return base + inc - v;
}
__device__ __forceinline__ void topk_unit(int u, const float* AFF, int* SELTOK, float* SELG, int* TOKSLOT, unsigned char* lds, int tid) {
    const bool isctx = u >= 64; const int uu = isctx ? u - 64 : u, b = uu >> 4, e = uu & 15;
    const int n = isctx ? 256 : 4096, rowbase = isctx ? MX + b * 256 : b * 4096;
    const unsigned cap = isctx ? 32u : 512u;
    const int slotbase = isctx ? SLOTX + e * 256 + b * 32 : e * 2048 + b * 512;
    unsigned* hist = (unsigned*)lds; unsigned* sh = hist + 256; unsigned* wt = hist + 272;
    unsigned key[8];
#pragma unroll
    for (int i = 0; i < 8; ++i) { const int t = tid * 8 + i; key[i] = (t < n) ? __builtin_bit_cast(unsigned, AFF[(size_t)(rowbase + t) * 16 + e]) : 0u; }
    unsigned prefix = 0u, krem = cap;
    for (int pass = 0; pass < 4; ++pass) {
        const int shift = 24 - 8 * pass;
        const unsigned hm = (pass == 0) ? 0u : (0xFFFFFFFFu << (shift + 8));
        if (tid < 256) hist[tid] = 0u;
        __syncthreads();
#pragma unroll
        for (int i = 0; i < 8; ++i) { const int t = tid * 8 + i; if (t < n && (key[i] & hm) == (prefix & hm)) atomicAdd(&hist[(key[i] >> shift) & 255u], 1u); }
        __syncthreads();
        if (tid < 256) { unsigned sfx = 0u; for (int d = 255; d > tid; --d) sfx += hist[d]; const unsigned mine = hist[tid];
            if (sfx < krem && sfx + mine >= krem) { sh[0] = (unsigned)tid; sh[1] = krem - sfx; } }
        __syncthreads();
        prefix |= sh[0] << shift; krem = sh[1];
        __syncthreads();
    }
    const unsigned T = prefix;
    unsigned ce = 0u;
#pragma unroll
    for (int i = 0; i < 8; ++i) { const int t = tid * 8 + i; ce += (t < n && key[i] == T) ? 1u : 0u; }
    unsigned eqr = block_excl_scan(ce, wt, tid);
    unsigned selm = 0u, cs = 0u;
#pragma unroll
    for (int i = 0; i < 8; ++i) { const int t = tid * 8 + i;
        if (t < n) { bool sel = key[i] > T; if (key[i] == T) { sel = eqr < krem; ++eqr; } if (sel) { selm |= 1u << i; ++cs; } } }
    unsigned slot = block_excl_scan(cs, wt, tid);
#pragma unroll
    for (int i = 0; i < 8; ++i) { const int t = tid * 8 + i;
        if (t < n) {
            int R = -1;
            if ((selm >> i) & 1u) { R = slotbase + (int)slot; ++slot; SELTOK[R] = rowbase + t; SELG[R] = __builtin_bit_cast(float, key[i]); }
            TOKSLOT[(size_t)(rowbase + t) * 16 + e] = R;
        } }
    if (isctx && b == 0 && tid < 128) { SELTOK[SLOTX + e * 256 + 128 + tid] = -1; SELG[SLOTX + e * 256 + 128 + tid] = 0.f; }
    __syncthreads();
}

template <bool CTX> __device__ __forceinline__ void combine_core(xres_t* xrow, int myR, const bf16* YS, const bf16* YS2, const f32x4 (&G2)[4], int lane, f32x4 (&v)[4], bool wb);
template <bool CTX> __device__ __forceinline__ void combine_row(xres_t* xrow, const int* tsrow, const bf16* YS, const bf16* YS2, const f32x4 (&G2)[4], int lane, f32x4 (&v)[4], bool wb = true) {
    const int myR = (lane < 16) ? tsrow[lane] : -1;
    xrow_load(xrow, lane, v);
    combine_core<CTX>(xrow, myR, YS, YS2, G2, lane, v, wb);
}
template <bool CTX> __device__ __forceinline__ void combine_core(xres_t* xrow, int myR, const bf16* YS, const bf16* YS2, const f32x4 (&G2)[4], int lane, f32x4 (&v)[4], bool wb) {
    f32x4 acc[4];
#pragma unroll
    for (int j = 0; j < 4; ++j) acc[j] = (f32x4){0.f, 0.f, 0.f, 0.f};
    unsigned mask = (unsigned)__ballot(myR >= 0);
    while (mask) {
        int R[4];
#pragma unroll
        for (int q = 0; q < 4; ++q) { R[q] = -1; if (mask) { const int e = __builtin_ctz(mask); R[q] = __builtin_amdgcn_readlane(myR, e); mask &= mask - 1u; } }
        u32x2 d[4][4], d2[4][4];
#pragma unroll
        for (int q = 0; q < 4; ++q) {
#pragma unroll
            for (int j = 0; j < 4; ++j) { d[q][j] = (u32x2){0u, 0u}; d2[q][j] = (u32x2){0u, 0u}; }
            if (R[q] >= 0) {
                const bf16* yr = YS + (size_t)R[q] * 1024 + 4 * lane;
#pragma unroll
                for (int j = 0; j < 4; ++j) d[q][j] = __builtin_nontemporal_load((const u32x2*)(yr + 256 * j));
                if (CTX) { const bf16* y2 = YS2 + (size_t)(R[q] - SLOTX) * 1024 + 4 * lane;
#pragma unroll
                    for (int j = 0; j < 4; ++j) d2[q][j] = *(const u32x2*)(y2 + 256 * j); }
            }
        }
#pragma unroll
        for (int q = 0; q < 4; ++q)
#pragma unroll
            for (int j = 0; j < 4; ++j) { acc[j] += (f32x4){bflo(d[q][j].x), bfhi(d[q][j].x), bflo(d[q][j].y), bfhi(d[q][j].y)};
                if (CTX) acc[j] += (f32x4){bflo(d2[q][j].x), bfhi(d2[q][j].x), bflo(d2[q][j].y), bfhi(d2[q][j].y)}; }
    }
#pragma unroll
    for (int j = 0; j < 4; ++j) v[j] += G2[j] * acc[j];
    if (wb) xrow_store(xrow, lane, v);
}

__device__ __forceinline__ void combine_gather4(unsigned& mask, int myR, const bf16* YS, int lane, u32x2 (&d)[4][4]) {
#pragma unroll
    for (int q = 0; q < 4; ++q) {
        int R = -1; if (mask) { const int e = __builtin_ctz(mask); R = __builtin_amdgcn_readlane(myR, e); mask &= mask - 1u; }
#pragma unroll
        for (int j = 0; j < 4; ++j) d[q][j] = (u32x2){0u, 0u};
        if (R >= 0) { const bf16* yr = YS + (size_t)R * 1024 + 4 * lane;
#pragma unroll
            for (int j = 0; j < 4; ++j) d[q][j] = __builtin_nontemporal_load((const u32x2*)(yr + 256 * j)); }
    }
}
__device__ __forceinline__ void combine_acc4(const u32x2 (&d)[4][4], f32x4 (&acc)[4]) {
#pragma unroll
    for (int q = 0; q < 4; ++q)
#pragma unroll
        for (int j = 0; j < 4; ++j) acc[j] += (f32x4){bflo(d[q][j].x), bfhi(d[q][j].x), bflo(d[q][j].y), bfhi(d[q][j].y)};
}
__device__ __forceinline__ void combine_pair(xres_t* xrow0, int myR0, int myR1, const bf16* YS, const f32x4 (&G2)[4], int lane, f32x4 (&v0)[4], f32x4 (&v1)[4], bool wb) {
    f32x4 a0[4], a1[4];
#pragma unroll
    for (int j = 0; j < 4; ++j) { a0[j] = (f32x4){0.f, 0.f, 0.f, 0.f}; a1[j] = (f32x4){0.f, 0.f, 0.f, 0.f}; }
    unsigned m0 = (unsigned)__ballot(myR0 >= 0), m1 = (unsigned)__ballot(myR1 >= 0);
    { u32x2 d0[4][4], d1[4][4];
      combine_gather4(m0, myR0, YS, lane, d0); combine_gather4(m1, myR1, YS, lane, d1);
      combine_acc4(d0, a0); combine_acc4(d1, a1); }
    while (m0) { u32x2 d[4][4]; combine_gather4(m0, myR0, YS, lane, d); combine_acc4(d, a0); }
    while (m1) { u32x2 d[4][4]; combine_gather4(m1, myR1, YS, lane, d); combine_acc4(d, a1); }
#pragma unroll
    for (int j = 0; j < 4; ++j) { v0[j] += G2[j] * a0[j]; v1[j] += G2[j] * a1[j]; }
    if (wb) { xrow_store(xrow0, lane, v0); xrow_store(xrow0 + 1024, lane, v1); }
}

struct Args { const float* in[22]; float* out; unsigned char* ws; int ph_lo, ph_hi; };
enum { I_X = 0, I_C, I_CTX, I_CCTX, I_WMOD, I_BMOD, I_N1G, I_N2G, I_WIN, I_CONVW, I_CONVB, I_WA, I_BA, I_WI, I_BI, I_LAM, I_WOUT, I_WR, I_WG, I_WU, I_WD, I_FG };

__global__ void __launch_bounds__(512, 2) fwd_kernel(Args args) {
    extern __shared__ __attribute__((aligned(16))) unsigned char lds_raw[];
    LAS unsigned char* lds = (LAS unsigned char*)lds_raw;
    const int G = gridDim.x, bx = blockIdx.x;
    const int vcu = (G % 8 == 0) ? (bx % 8) * (G / 8) + bx / 8 : bx;
    if (threadIdx.x < 64) ((LAS unsigned*)(lds + MISC_OFF))[threadIdx.x] = 0u;
    __syncthreads();
    const int lo = args.ph_lo, hi = args.ph_hi;
    XcdBarrier bar; bar.bar = (unsigned*)(args.ws + WS_CTL) + CW_BAR; bar.x = 0; bar.st = nullptr;
    if (hi - lo > 1) bar = xcd_barrier_post((unsigned*)(args.ws + WS_CTL) + CW_BAR, (volatile LAS unsigned*)(lds + MISC_OFF) + 8);
#ifdef ONLY_SITE
#define IN(k) ((((k) < 2 ? (k) : 2 + ((k) - 2) % 10) == ONLY_SITE) && lo <= (k) && (k) < hi)
#else
#define IN(k) (lo <= (k) && (k) < hi)
#endif
#ifndef DUP_BAR
#define DUP_BAR 0
#endif
#define SEAM(k) do { if (IN(k) && IN((k) + 1)) { xcd_barrier(bar); if (DUP_BAR) xcd_barrier(bar); } } while (0)
#define P_BEGIN int tid = threadIdx.x; asm volatile("" : "+v"(tid)); const int lane = tid & 63, wv = __builtin_amdgcn_readfirstlane(tid >> 6); (void)lane; (void)wv; \
    unsigned char* ws = args.ws; asm volatile("" : "+s"(ws)); const float* const* inp = (const float* const*)__builtin_amdgcn_kernarg_segment_ptr(); asm volatile("" : "+s"(inp)); \
    const int gw = vcu * 8 + wv, NGW = G * 8; (void)gw; (void)NGW;
#define WSP(T, off) ((T*)(ws + (off)))
#ifndef DUP_SITE
#define DUP_SITE -1
#endif
#define DUPLOOP(s_) for (int rep_ = 0; rep_ < ((s_) == DUP_SITE ? 2 : 1); ++rep_)

#ifndef PASSA_STAGGER
#define PASSA_STAGGER 1
#endif
#ifndef PROBE_P0
#define PROBE_P0 0
#endif
#define PRB(n_) for (int prb_ = 0; prb_ < (PROBE_P0 == (n_) ? 2 : 1); ++prb_)
    if (IN(0)) DUPLOOP(0) { P_BEGIN
        bf16* WIN = WSP(bf16, WS_WIN); bf16* WOUT = WSP(bf16, WS_WOUT); float* MOD = WSP(float, WS_MOD);
        PRB(4) { const int l = bx >> 7, kb = (bx >> 3) & 15, g = (bx >> 1) & 3, it = bx & 1; if (bx < 256) fold_item(inp[I_WIN] + (size_t)l * 1024 * 1536, WIN + (size_t)l * 2048 * 1024, kb, g, it, lds_raw, tid); }
        PRB(1) if (bx >= 64) { const int it = bx - 64, l = it / 96, jb = it % 96;
            mod_item(inp[I_C], inp[I_CCTX], inp[I_WMOD] + (size_t)l * 1024 * 6144, inp[I_BMOD] + l * 6144, MOD + l * 5 * 6144, jb, lds_raw, tid); }
        else PRB(2) tables_items(ws, inp[I_WA], inp[I_WI], bx * 512 + tid, 64 * 512);
        PRB(3) for (int it = gw; it < 2 * 512; it += NGW) { const int l = it >> 9, r = it & 511, kb = r >> 5, nb = r & 31;
            tr_item(inp[I_WIN] + (size_t)l * 1024 * 1536, 1024, 1536, kb * 64, 512 + nb * 32, WIN + (size_t)l * 2048 * 1024, 1024 + nb * 32, lane); }
        PRB(3) for (int it = gw; it < 2 * 512; it += NGW) { const int l = it >> 9, r = it & 511, kb = r >> 5, nb = r & 31;
            tr_item(inp[I_WOUT] + (size_t)l * 1024 * 1024, 1024, 1024, kb * 64, nb * 32, WOUT + (size_t)l * 1024 * 1024, nb * 32, lane); }
    }
    SEAM(0);

    if (IN(1)) DUPLOOP(1) { P_BEGIN
        const float* MOD = WSP(float, WS_MOD); const float* PE = WSP(float, WS_PE); xres_t* XRES = WSP(xres_t, WS_XRES); bf16* HN = WSP(bf16, WS_HN);
        const int w = vcu, b = w >> 6;
        f32x4 A[4], Bv[4];
        load_modAB(inp[I_N1G], MOD, b, 0, 1024, lane, A, Bv);
        const float* xin = inp[I_X];
        for (int i = 0; i < 8; ++i) {
            const int row = 64 * w + 8 * wv + i, t = row & 4095, pr = t >> 6, pc = t & 63;
            f32x4 v[4];
#pragma unroll
            for (int j = 0; j < 4; ++j) { const int c = 4 * lane + 256 * j;
                const f32x4 pe = (j < 2) ? *(const f32x4*)(PE + pr * 512 + c) : *(const f32x4*)(PE + pc * 512 + c - 512);
                v[j] = __builtin_nontemporal_load((const f32x4*)(xin + (size_t)row * 1024 + c)) + pe; }
            xrow_store(XRES + (size_t)row * 1024, lane, v);
            const float rstd = row_rstd(v);
#pragma unroll
            for (int j = 0; j < 4; ++j) v[j] = v[j] * rstd * A[j] + Bv[j];
            row_store_bf16(HN + (size_t)row * 1024, v, lane);
        }
        if (wv < 4) {
            load_modAB(inp[I_N1G], MOD, 4, 0, 1024, lane, A, Bv);
            const int cr = 4 * w + wv, row = MX + cr;
            const float* cin = inp[I_CTX];
            f32x4 v[4];
#pragma unroll
            for (int j = 0; j < 4; ++j) { const int c = 4 * lane + 256 * j; v[j] = *(const f32x4*)(cin + (size_t)cr * 1024 + c); }
            xrow_store(XRES + (size_t)row * 1024, lane, v);
            const float rstd = row_rstd(v);
#pragma unroll
            for (int j = 0; j < 4; ++j) v[j] = v[j] * rstd * A[j] + Bv[j];
            row_store_bf16(HN + (size_t)row * 1024, v, lane);
        }
    }
    SEAM(1);

    for (int l = 0; l < DEPTH; ++l) {
        const int pb = 2 + 10 * l;
        const bool last = (l == DEPTH - 1);
        if (IN(pb + 0)) DUPLOOP(2) { P_BEGIN
            const int NGp = NG_PROJ0;
            pg8::Gemm g{WSP(bf16, WS_HN), WSP(bf16, WS_WIN) + (size_t)l * 2048 * 1024, MALL, NPROJ, D, D, nullptr}; pg8::StaticOrder S; S.init(MALL, NPROJ, NGp, bx);
            EpiProj E{WSP(bf16, WS_VX), WSP(bf16, WS_VC), WSP(bf16, WS_UX), WSP(bf16, WS_UG)};
            if (bx < NGp) pg8::gemm_phase<EpiProj, pg8::StaticOrder, true, true>(lds, g, S, E);
            const ConvCtx cc{inp[I_WG], inp[I_WU], inp[I_WD], WSP(bf16, WS_BT1), WSP(bf16, WS_BT2), l, 0, 0, 0};
            if (l == 0) { if (bx >= NG_PROJ0) conv_tail(cc, cv_nA(0) + CV_FOUR, bx - NG_PROJ0, 256 - NG_PROJ0, TQ_PROJ0, lane, wv); }
            else if (bx >= NG_PROJ0) conv_tail(cc, cv_nA(l) + CV_FOUR + NT_G1 + NT_G2, bx - NG_PROJ0, 256 - NG_PROJ0, TQ_PROJ1, lane, wv);
        }
        SEAM(pb + 0);
        if (IN(pb + 1)) DUPLOOP(3) { P_BEGIN
            bf16* MIX = WSP(bf16, WS_MIX);
            const int ord = PASSA_STAGGER ? ((bx >> 3) & 1) : 0;
#define PASSA_FOUR() do { const ConvCtx ccf{inp[I_WG], inp[I_WU], inp[I_WD], WSP(bf16, WS_BT1), WSP(bf16, WS_BT2), l, 0, cv_nA(l), 0}; \
                for (int u = vcu; u < 512; u += G) fourier_unit(WSP(bf16, WS_VX), WSP(bf16, WS_M1), WSP(bf16, WS_M3), MIX, u >> 7, u & 127, ccf, u, lds, tid); \
                if (!last) for (int u = bx; u < 64; u += G) fourier_ctx_unit(WSP(bf16, WS_VC), WSP(bf16, WS_MCT), MIX, u >> 4, u & 15, tid); } while (0)
#define PASSA_SCAN() scan_phase<false>(WSP(bf16, WS_UX), WSP(bf16, WS_UG), MIX, WSP(bf16, WS_GWT), WSP(float, WS_SUMM), inp[I_CONVW] + l * 4 * 512, inp[I_CONVB] + l * 512, inp[I_BA] + l * 1024, inp[I_BI] + l * 1024, \
                                      inp[I_LAM] + l * 1024, l, bx, false, ConvCtx{inp[I_WG], inp[I_WU], inp[I_WD], WSP(bf16, WS_BT1), WSP(bf16, WS_BT2), l, 0, cv_nA(l), 0}, lds, tid)
            if (ord == 0) { PASSA_FOUR(); __syncthreads(); PASSA_SCAN(); } else { PASSA_SCAN(); __syncthreads(); PASSA_FOUR(); }
#undef PASSA_FOUR
#undef PASSA_SCAN
        }
        SEAM(pb + 1);
        if (IN(pb + 2)) DUPLOOP(4) { P_BEGIN
            scan_phase<true>(WSP(bf16, WS_UX), WSP(bf16, WS_UG), WSP(bf16, WS_MIX), WSP(bf16, WS_GWT), WSP(float, WS_SUMM), inp[I_CONVW] + l * 4 * 512, inp[I_CONVB] + l * 512, inp[I_BA] + l * 1024,
                             inp[I_BI] + l * 1024, inp[I_LAM] + l * 1024, l, bx, last, ConvCtx{inp[I_WG], inp[I_WU], inp[I_WD], WSP(bf16, WS_BT1), WSP(bf16, WS_BT2), l, 1, 0, cv_nA(l) + CV_FOUR + (l == 0 ? NTAIL_L0 : NTAIL_L1)}, lds, tid);
        }
        SEAM(pb + 2);
        if (IN(pb + 3)) DUPLOOP(5) { P_BEGIN
            const int Mo = last ? MX : MALL;
            const int NGo = last ? G : NG_OUT0;
            pg8::Gemm g{WSP(bf16, WS_MIX), WSP(bf16, WS_WOUT) + (size_t)l * 1024 * 1024, Mo, D, D, D, nullptr}; pg8::StaticOrder S; S.init(Mo, D, NGo, bx);
            EpiOut E{WSP(xres_t, WS_XRES), WSP(float, WS_MOD) + l * 5 * 6144, (DUP_SITE == 5 && rep_ == 0) ? 0.f : 1.f};
            if (bx < NGo) pg8::gemm_phase<EpiOut, pg8::StaticOrder, true, true>(lds, g, S, E);
            if (!last && bx >= NG_OUT0) {
                const ConvCtx cc{inp[I_WG], inp[I_WU], inp[I_WD], WSP(bf16, WS_BT1), WSP(bf16, WS_BT2), 0, 0, 0, 0};
                conv_tail(cc, cv_nA(0) + CV_FOUR + NT_PROJ0, bx - NG_OUT0, 256 - NG_OUT0, TQ_OUT0, lane, wv);
            }
        }
        SEAM(pb + 3);
        if (IN(pb + 4)) DUPLOOP(6) { P_BEGIN
            const float* modl = WSP(float, WS_MOD) + l * 5 * 6144; xres_t* XRES = WSP(xres_t, WS_XRES); bf16* HN = WSP(bf16, WS_HN); float* AFF = WSP(float, WS_AFF);
            const float* wr = inp[I_WR] + (size_t)l * 1024 * 16;
            for (int i = tid; i < 4096; i += 512) *(f32x4*)(lds_raw + wr_addr(i >> 2) + (i & 3) * 16) = *(const f32x4*)(wr + (size_t)i * 4);
            __syncthreads();
            const int w = vcu, b = w >> 6;
            f32x4 A[4], Bv[4];
            load_modAB(inp[I_N2G] + l * 1024, modl, b, 3072, 4096, lane, A, Bv);
#pragma unroll 1
            for (int i = 0; i < 8; i += 2) { const int row = 64 * w + 8 * wv + i;
                norm2_router_rows<2>(XRES + (size_t)row * 1024, HN + (size_t)row * HNRS, AFF + (size_t)row * 16, A, Bv, lds_raw, lane); }
            if (!last && wv < 4) {
                load_modAB(inp[I_N2G] + l * 1024, modl, 4, 3072, 4096, lane, A, Bv);
                const int row = MX + 4 * w + wv;
                norm2_router_rows<1>(XRES + (size_t)row * 1024, HN + (size_t)row * HNRS, AFF + (size_t)row * 16, A, Bv, lds_raw, lane);
            }
            __syncthreads();
        }
        SEAM(pb + 4);
        if (IN(pb + 5)) DUPLOOP(7) { P_BEGIN
            const int nu = last ? 64 : 128;
            for (int u = bx; u < nu; u += G) topk_unit(u, WSP(float, WS_AFF), WSP(int, WS_SELTOK), WSP(float, WS_SELG), WSP(int, WS_TOKSLOT), lds_raw, tid);
        }
        SEAM(pb + 5);
        if (IN(pb + 7)) DUPLOOP(9) { P_BEGIN
            pg8::Gemm g{WSP(bf16, WS_HN), WSP(bf16, WS_BT1) + (size_t)l * 16 * 5632 * 1024, SLOTALL, 16 * 5632, D, D, WSP(int, WS_SELTOK)};   GroupedGatherOrder S; S.init(22, last ? 8 : 9, G, bx, 16, 0, G1_SEQ, G1_MG);
            EpiG1 E{WSP(bf16, WS_HID), 22};
            pg8::gemm_phase<EpiG1, GroupedGatherOrder, true, true>(lds, g, S, E);
            if (!last && bx >= 96) {
                const ConvCtx cc{inp[I_WG], inp[I_WU], inp[I_WD], WSP(bf16, WS_BT1), WSP(bf16, WS_BT2), 1, 0, 0, 0};
                conv_tail(cc, cv_nA(1) + CV_FOUR, bx - 96, 160, TQ_G1, lane, wv);
            }
        }
        SEAM(pb + 7);
        if (IN(pb + 8)) DUPLOOP(10) { P_BEGIN
            EpiG2 E{WSP(bf16, WS_YS), WSP(bf16, WS_YS2), WSP(float, WS_SELG)};
            { pg8::Gemm g{WSP(bf16, WS_HID), WSP(bf16, WS_BT2) + (size_t)l * 16 * 1024 * DFF, SLOTALL, 16 * 1024, DFF, DFF, nullptr}; GroupedOrder S; S.init(4, 8, G, bx, 44, 1, 0, G2_MG);
              pg8::gemm_phase<EpiG2, GroupedOrder, true, true>(lds, g, S, E); }
            if (!last) { pg8::Gemm g{WSP(bf16, WS_HID), WSP(bf16, WS_BT2) + (size_t)l * 16 * 1024 * DFF, SLOTALL, 16 * 1024, DFF / 2, DFF, nullptr}; CtxSplitOrder S; S.init(G, bx, DFF / 2);
              pg8::gemm_phase<EpiG2, CtxSplitOrder, true, true>(lds, g, S, E);
              if (bx >= 128) {
                const ConvCtx cc{inp[I_WG], inp[I_WU], inp[I_WD], WSP(bf16, WS_BT1), WSP(bf16, WS_BT2), 1, 0, 0, 0};
                conv_tail(cc, cv_nA(1) + CV_FOUR + NT_G1, bx - 128, 128, TQ_G2, lane, wv);
              } }
        }
        SEAM(pb + 8);
        if (IN(pb + 9)) DUPLOOP(11) { P_BEGIN
            const float* MOD = WSP(float, WS_MOD); const float* modl = MOD + l * 5 * 6144; xres_t* XRES = WSP(xres_t, WS_XRES); bf16* HN = WSP(bf16, WS_HN);
            const int* TOKSLOT = WSP(int, WS_TOKSLOT); const bf16* YS = WSP(bf16, WS_YS);
            const int w = vcu, b = w >> 6;
            f32x4 G2[4], A[4], Bv[4];
#pragma unroll
            for (int j = 0; j < 4; ++j) G2[j] = *(const f32x4*)(modl + b * 6144 + 5120 + 4 * lane + 256 * j) * ((DUP_SITE == 11 && rep_ == 0) ? 0.f : 1.f);
            if (!last) load_modAB(inp[I_N1G] + (l + 1) * 1024, MOD + (l + 1) * 5 * 6144, b, 0, 1024, lane, A, Bv);
            else { const float* fg = inp[I_FG];
#pragma unroll
                for (int j = 0; j < 4; ++j) { A[j] = *(const f32x4*)(fg + 4 * lane + 256 * j); Bv[j] = (f32x4){0.f, 0.f, 0.f, 0.f}; }
            }
            float* outp = args.out;
            const int ts01 = TOKSLOT[(size_t)(64 * w + 8 * wv) * 16 + lane], ts47 = TOKSLOT[(size_t)(64 * w + 8 * wv + 4) * 16 + lane];
            for (int i = 0; i < 8; i += 2) {
                const int row = 64 * w + 8 * wv + i;
                f32x4 v[4], v2[4];
                const int tsq = (i < 4) ? ts01 : ts47;
                int myR0 = __shfl(tsq, ((i & 3) << 4) | (lane & 15)), myR1 = __shfl(tsq, (((i + 1) & 3) << 4) | (lane & 15)); if (lane >= 16) { myR0 = -1; myR1 = -1; }
                xrow_load(XRES + (size_t)row * 1024, lane, v); xrow_load(XRES + (size_t)(row + 1) * 1024, lane, v2);
                combine_pair(XRES + (size_t)row * 1024, myR0, myR1, YS, G2, lane, v, v2, !last);
                const float rstd = row_rstd(v), rstd2 = row_rstd(v2);
#pragma unroll
                for (int j = 0; j < 4; ++j) { v[j] = v[j] * rstd * A[j] + Bv[j]; v2[j] = v2[j] * rstd2 * A[j] + Bv[j]; }
                if (!last) { row_store_bf16(HN + (size_t)row * 1024, v, lane); row_store_bf16(HN + (size_t)(row + 1) * 1024, v2, lane); }
                else {
#pragma unroll
                    for (int j = 0; j < 4; ++j) { __builtin_nontemporal_store(v[j], (f32x4*)(outp + (size_t)row * 1024 + 4 * lane + 256 * j));
                        __builtin_nontemporal_store(v2[j], (f32x4*)(outp + (size_t)(row + 1) * 1024 + 4 * lane + 256 * j)); }
                }
            }
            if (!last && wv < 4) {
#pragma unroll
                for (int j = 0; j < 4; ++j) G2[j] = *(const f32x4*)(modl + 4 * 6144 + 5120 + 4 * lane + 256 * j) * ((DUP_SITE == 11 && rep_ == 0) ? 0.f : 1.f);
                load_modAB(inp[I_N1G] + (l + 1) * 1024, MOD + (l + 1) * 5 * 6144, 4, 0, 1024, lane, A, Bv);
                const int row = MX + 4 * w + wv;
                f32x4 v[4];
                combine_row<true>(XRES + (size_t)row * 1024, TOKSLOT + (size_t)row * 16, YS, WSP(bf16, WS_YS2), G2, lane, v);
                const float rstd = row_rstd(v);
#pragma unroll
                for (int j = 0; j < 4; ++j) v[j] = v[j] * rstd * A[j] + Bv[j];
                row_store_bf16(HN + (size_t)row * 1024, v, lane);
            }
        }
        if (!last) SEAM(pb + 9);
    }
#undef IN
#undef SEAM
}

extern "C" void kernel_launch(void* const* d_in, const int* in_sizes, int n_in, void* d_out, int out_size, void* d_ws, size_t ws_size, hipStream_t stream) {
    static int grid = 0;
    if (grid == 0) {
        if (n_in != 22 || out_size != MX * D || ws_size < WS_END) { fprintf(stderr, "kernel_launch: unexpected shapes (n_in %d out %d ws %zu)\n", n_in, out_size, ws_size); grid = -1; return; }
        int dev = 0, cus = 0, per_cu = 0;
        if (hipGetDevice(&dev) != hipSuccess || hipDeviceGetAttribute(&cus, hipDeviceAttributeMultiprocessorCount, dev) != hipSuccess) { grid = -1; return; }
        if (hipFuncSetAttribute((const void*)fwd_kernel, hipFuncAttributeMaxDynamicSharedMemorySize, LDS_BYTES) != hipSuccess) { fprintf(stderr, "kernel_launch: hipFuncSetAttribute failed\n"); grid = -1; return; }
        if (hipOccupancyMaxActiveBlocksPerMultiprocessor(&per_cu, (const void*)fwd_kernel, 512, LDS_BYTES) != hipSuccess || per_cu < 1) { fprintf(stderr, "kernel_launch: occupancy query reports %d\n", per_cu); }
        (void)hipGetLastError();
        grid = cus;
        if (grid != 256) { fprintf(stderr, "kernel_launch: this kernel is laid out for 256 CUs, found %d\n", cus); grid = -1; return; }
    }
    if (grid < 0) return;
    (void)hipMemsetAsync((char*)d_ws + WS_CTL, 0, CTL_ZERO_BYTES, stream);
    Args a{};
    for (int i = 0; i < 22; ++i) a.in[i] = (const float*)d_in[i];
    a.out = (float*)d_out; a.ws = (unsigned char*)d_ws;
#if MK_SPLIT
    for (int p = 0; p < NPH; ++p) { a.ph_lo = p; a.ph_hi = p + 1; hipLaunchKernelGGL(fwd_kernel, dim3(grid), dim3(512), LDS_BYTES, stream, a); }
#else
    a.ph_lo = 0; a.ph_hi = NPH;
    hipLaunchKernelGGL(fwd_kernel, dim3(grid), dim3(512), LDS_BYTES, stream, a);
#endif
}
```
